# Optimizing an MI355X kernel written in HIP

```python
import math
import jax, jax.numpy as jnp
from jax import lax
import numpy as np

D_MODEL = 1024
BATCH = 16
SEQ = 4096
DEPTH = 1

SB_WIDTH = D_MODEL // 2
SB_HEAD_DIM = 64
SB_HEADS = SB_WIDTH // SB_HEAD_DIM
ML_WIDTH = D_MODEL - SB_WIDTH
ML_HEADS = 4
ML_HEAD_DIM = ML_WIDTH // ML_HEADS
MIX_WIDTH = SB_WIDTH + ML_WIDTH
Q_BLOCK = 128
ML_CHUNK = 64
CONV_WIDTH = 4
EPS = 1e-6
IN_SPLITS = [SB_WIDTH] * 4 + [ML_WIDTH] * 5 + [ML_HEADS, ML_HEADS]
IN_WIDTH = sum(IN_SPLITS)

kernel_name = "hymba_stickbreaking_mlstm_adaln"


def _rmsnorm(t, gain):
    tf = t.astype(jnp.float32)
    tf = tf * lax.rsqrt(jnp.mean(tf * tf, axis=-1, keepdims=True) + EPS)
    return (tf * gain.astype(jnp.float32)).astype(t.dtype)


def _to_heads(t, n_heads):
    b, s, _ = t.shape
    return t.reshape(b, s, n_heads, -1).transpose(0, 2, 1, 3)


def _from_heads(t):
    b, h, s, d = t.shape
    return t.transpose(0, 2, 1, 3).reshape(b, s, h * d)


def _stick_breaking(q, k, v):
    seq = q.shape[2]
    scale = 1.0 / math.sqrt(q.shape[-1])
    outs = []
    for blk in range(seq // Q_BLOCK):
        t0 = blk * Q_BLOCK
        t1 = t0 + Q_BLOCK
        qb = q[:, :, t0:t1]
        kb = k[:, :, :t1]
        vb = v[:, :, :t1]
        z = jnp.einsum('bhqd,bhkd->bhqk', qb, kb).astype(jnp.float32) * scale
        qpos = t0 + jnp.arange(Q_BLOCK)[:, None]
        kpos = jnp.arange(t1)[None, :]
        strict = kpos < qpos
        log_1mb = jnp.where(strict, jax.nn.log_sigmoid(-z), 0.0)
        between = lax.cumsum(log_1mb, axis=3, reverse=True) - log_1mb
        a = jnp.where(strict, jnp.exp(jax.nn.log_sigmoid(z) + between), 0.0)
        outs.append(jnp.einsum('bhqk,bhkd->bhqd', a.astype(v.dtype), vb))
    return jnp.concatenate(outs, axis=2)


def _mlstm(q, k, v, i_pre, log_f):
    b, h, s, d = q.shape
    nc = s // ML_CHUNK
    f32 = jnp.float32
    qs = (q.astype(f32) * (1.0 / math.sqrt(d)))

    def chunks4(t):
        return t.reshape(b, h, nc, ML_CHUNK, -1).transpose(2, 0, 1, 3, 4)

    def chunks3(t):
        return t.reshape(b, h, nc, ML_CHUNK).transpose(2, 0, 1, 3)

    xs = (chunks4(qs), chunks4(k.astype(f32)), chunks4(v.astype(f32)),
          chunks3(i_pre.astype(f32)), chunks3(log_f.astype(f32)))
    causal = jnp.tril(jnp.ones((ML_CHUNK, ML_CHUNK), dtype=bool))

    def step(carry, xc):
        c_mat, n_vec, m_prev = carry
        qc, kc, vc, ic, fc = xc
        bcum = jnp.cumsum(fc, axis=-1)
        log_d = bcum[..., :, None] - bcum[..., None, :] + ic[..., None, :]
        log_d = jnp.where(causal, log_d, -jnp.inf)
        inter = bcum + m_prev[..., None]
        m_t = jnp.maximum(inter, jnp.max(log_d, axis=-1))
        d_mat = jnp.exp(log_d - m_t[..., None])
        g_inter = jnp.exp(inter - m_t)
        sc = jnp.einsum('bhld,bhsd->bhls', qc, kc) * d_mat
        num = (jnp.einsum('bhls,bhse->bhle', sc, vc)
               + g_inter[..., None] * jnp.einsum('bhld,bhde->bhle', qc, c_mat))
        den = jnp.sum(sc, axis=-1) + g_inter * jnp.einsum('bhld,bhd->bhl', qc, n_vec)
        h_out = num / jnp.maximum(jnp.abs(den), jnp.exp(-m_t))[..., None]
        b_last = bcum[..., -1]
        w_log = b_last[..., None] - bcum + ic
        m_new = jnp.maximum(b_last + m_prev, jnp.max(w_log, axis=-1))
        w = jnp.exp(w_log - m_new[..., None])
        g_c = jnp.exp(b_last + m_prev - m_new)
        c_new = g_c[..., None, None] * c_mat + jnp.einsum('bhs,bhsd,bhse->bhde', w, kc, vc)
        n_new = g_c[..., None] * n_vec + jnp.einsum('bhs,bhsd->bhd', w, kc)
        return (c_new, n_new, m_new), h_out

    init = (jnp.zeros((b, h, d, d), f32), jnp.zeros((b, h, d), f32), jnp.zeros((b, h), f32))
    _, hs = lax.scan(step, init, xs)
    return hs.transpose(1, 2, 0, 3, 4).reshape(b, h, s, d)


def _layer(x, c, w_ada, b_ada, norm_gain, w_in, b_gates, q_norm_gain, k_norm_gain,
           conv_w, conv_b, ml_norm_gain, w_out):
    bsz, seq, _ = x.shape
    mod = jax.nn.silu(c) @ w_ada + b_ada
    shift, scale, gate = jnp.split(mod, 3, axis=-1)
    hn = _rmsnorm(x, norm_gain) * (1.0 + scale[:, None, :]) + shift[:, None, :]
    u = hn @ w_in
    idx = list(np.cumsum(IN_SPLITS)[:-1])
    sb_q, sb_k, sb_v, sb_z, ml_q, ml_k, ml_v, ml_o, ml_z, ml_i, ml_f = jnp.split(u, idx, axis=-1)

    qh = _rmsnorm(_to_heads(sb_q, SB_HEADS), q_norm_gain)
    kh = _rmsnorm(_to_heads(sb_k, SB_HEADS), k_norm_gain)
    vh = _to_heads(sb_v, SB_HEADS)
    sb_out = _from_heads(_stick_breaking(qh, kh, vh))

    qk = jnp.concatenate([ml_q, ml_k], axis=-1)
    qk = lax.conv_general_dilated(
        qk, conv_w[:, None, :].astype(qk.dtype), window_strides=(1,),
        padding=[(CONV_WIDTH - 1, 0)], dimension_numbers=('NWC', 'WIO', 'NWC'),
        feature_group_count=2 * ML_WIDTH)
    qk = jax.nn.silu(qk + conv_b)
    mq, mk = jnp.split(qk, 2, axis=-1)
    gates = jnp.concatenate([ml_i, ml_f], axis=-1) + b_gates
    i_pre = gates[..., :ML_HEADS].transpose(0, 2, 1)
    log_f = jax.nn.log_sigmoid(gates[..., ML_HEADS:].astype(jnp.float32)).transpose(0, 2, 1)
    ml_h = _mlstm(_to_heads(mq, ML_HEADS), _to_heads(mk, ML_HEADS), _to_heads(ml_v, ML_HEADS),
                  i_pre, log_f)
    ml_h = _rmsnorm(ml_h, ml_norm_gain.reshape(ML_HEADS, 1, ML_HEAD_DIM)).astype(x.dtype)
    ml_out = jax.nn.sigmoid(ml_o) * _from_heads(ml_h)

    y = jnp.concatenate([sb_out * jax.nn.silu(sb_z), ml_out * jax.nn.silu(ml_z)], axis=-1)
    y = y @ w_out
    return x + gate[:, None, :] * y


def setup_inputs(seed: int = 0) -> dict:
    key = jax.random.key(seed)
    ks = jax.random.split(key, 16)
    f32 = jnp.float32
    nrm = lambda k, shp: jax.random.normal(k, shp, f32)
    x = nrm(ks[0], (BATCH, SEQ, D_MODEL))
    c = nrm(ks[1], (BATCH, D_MODEL))
    w_ada = nrm(ks[2], (DEPTH, D_MODEL, 3 * D_MODEL)) * (0.5 * D_MODEL ** -0.5)
    b_ada = nrm(ks[3], (DEPTH, 3 * D_MODEL)) * 0.02
    norm_gain = 1.0 + 0.02 * nrm(ks[4], (DEPTH, D_MODEL))
    w_in = nrm(ks[5], (DEPTH, D_MODEL, IN_WIDTH)) * D_MODEL ** -0.5
    i_bias = 0.02 * nrm(ks[6], (DEPTH, ML_HEADS))
    f_bias = jnp.linspace(3.0, 6.0, ML_HEADS, dtype=f32)[None, :] + 0.02 * nrm(ks[7], (DEPTH, ML_HEADS))
    b_gates = jnp.concatenate([i_bias, f_bias], axis=-1)
    q_norm_gain = 1.0 + 0.02 * nrm(ks[8], (DEPTH, SB_HEAD_DIM))
    k_norm_gain = 1.0 + 0.02 * nrm(ks[9], (DEPTH, SB_HEAD_DIM))
    conv_w = nrm(ks[10], (DEPTH, CONV_WIDTH, 2 * ML_WIDTH)) * CONV_WIDTH ** -0.5
    conv_b = 0.02 * nrm(ks[11], (DEPTH, 2 * ML_WIDTH))
    ml_norm_gain = 1.0 + 0.02 * nrm(ks[12], (DEPTH, ML_WIDTH))
    w_out = nrm(ks[13], (DEPTH, MIX_WIDTH, D_MODEL)) * MIX_WIDTH ** -0.5
    return {"x": x, "c": c, "w_ada": w_ada, "b_ada": b_ada, "norm_gain": norm_gain,
            "w_in": w_in, "b_gates": b_gates, "q_norm_gain": q_norm_gain,
            "k_norm_gain": k_norm_gain, "conv_w": conv_w, "conv_b": conv_b,
            "ml_norm_gain": ml_norm_gain, "w_out": w_out}


def reference(x, c, w_ada, b_ada, norm_gain, w_in, b_gates, q_norm_gain, k_norm_gain,
              conv_w, conv_b, ml_norm_gain, w_out):
    h = x
    for layer in range(DEPTH):
        h = _layer(h, c, w_ada[layer], b_ada[layer], norm_gain[layer], w_in[layer],
                   b_gates[layer], q_norm_gain[layer], k_norm_gain[layer], conv_w[layer],
                   conv_b[layer], ml_norm_gain[layer], w_out[layer])
    return h
```

```cpp
#include <hip/hip_runtime.h>
#include <hip/hip_cooperative_groups.h>
#include <cstdio>
namespace cg = cooperative_groups;

#define DI __device__ __forceinline__
#define LAS __attribute__((address_space(3)))
typedef unsigned short bf16_t;
typedef short bf16x8 __attribute__((ext_vector_type(8)));
typedef short s16x4 __attribute__((ext_vector_type(4)));
typedef float f32x4 __attribute__((ext_vector_type(4)));
typedef float f32x2 __attribute__((ext_vector_type(2)));
typedef float f32x16 __attribute__((ext_vector_type(16)));
typedef unsigned u32x4 __attribute__((ext_vector_type(4)));
typedef unsigned u32x2 __attribute__((ext_vector_type(2)));

constexpr int SEQ = 4096, NB = 16, DM = 1024, NTOK = NB * SEQ, NU = 4608, WIN_LD = 4616;
constexpr float EPS = 1e-6f, LOG2E = 1.4426950408889634f;

struct Params {
  const float* x; const float* c; const float* w_ada; const float* b_ada; const float* norm_gain; const float* w_in;
  const float* b_gates; const float* qg; const float* kg; const float* conv_w; const float* conv_b; const float* mlg; const float* w_out;
  float* out; unsigned* bar; float* mod; float* gates; float* gch; float* Lst; bf16_t* w1t; bf16_t* w2t; bf16_t* hn; bf16_t* u; bf16_t* y;
};

DI bf16_t f2bf(float f) { unsigned u = __float_as_uint(f); u += 0x7FFFu + ((u >> 16) & 1u); return (bf16_t)(u >> 16); }
DI float bf2f(bf16_t b) { return __uint_as_float(((unsigned)b) << 16); }
typedef __bf16 bf16x2_t __attribute__((ext_vector_type(2)));
DI unsigned pack2(float lo, float hi) { const f32x2 v = {lo, hi}; return __builtin_bit_cast(unsigned, __builtin_convertvector(v, bf16x2_t)); }
DI float bflo(unsigned w) { return __uint_as_float(w << 16); }
DI float bfhi(unsigned w) { return __uint_as_float(w & 0xFFFF0000u); }
DI float sigmf(float v) { return __builtin_amdgcn_rcpf(1.0f + __builtin_amdgcn_exp2f(-LOG2E * v)); }
DI float siluf(float v) { return v * sigmf(v); }
DI float wave_sum(float v) { for (int o = 32; o >= 1; o >>= 1) v += __shfl_xor(v, o); return v; }


#define XB_TMO      128
#define XB_XCNT(j)  (256  + 64 * (j))
#define XB_XSUB(j)  (1280 + 64 * (j))
#define XB_XGEN(j)  (2304 + 64 * (j))
#define XB_TOP      3328
#define XB_TOPGEN   3392
#define XCD_BAR_WORDS 3456
#define XB_SPIN_CAP (1u << 18)
DI unsigned xb_ld(unsigned* p)              { return __hip_atomic_load(p, __ATOMIC_RELAXED, __HIP_MEMORY_SCOPE_AGENT); }
DI unsigned xb_add(unsigned* p, unsigned v) { return __hip_atomic_fetch_add(p, v, __ATOMIC_RELAXED, __HIP_MEMORY_SCOPE_AGENT); }
DI unsigned xb_xcc_id() { return (unsigned)__builtin_amdgcn_s_getreg((3 << 11) | 20) & 0xFu; }
#define XB_SPIN(cond, bar) do { unsigned _sp = 0; while (cond) { __builtin_amdgcn_s_sleep(1); \
    if ((++_sp & 255u) == 0u) { if (xb_ld(&(bar)[XB_TMO])) break; if (_sp > XB_SPIN_CAP) { atomicAdd(&(bar)[XB_TMO], 1u); break; } } } } while (0)
struct XcdBarrier { unsigned* bar; unsigned x; volatile LAS unsigned* st; };
DI XcdBarrier xcd_barrier_post(unsigned* bar, volatile LAS unsigned* st) {
  XcdBarrier b; b.bar = bar; b.x = xb_xcc_id(); b.st = st;
  if (threadIdx.x == 0) (void)xb_add(&bar[XB_XCNT(b.x)], 1u);
  return b;
}
DI void xcd_barrier_complete(unsigned* bar, unsigned x, unsigned& nloc, unsigned& nx) {
  const unsigned G = gridDim.x * gridDim.y * gridDim.z;
  unsigned sum, cnt, mine, sp = 0u;
  for (;;) {
    sum = 0u; cnt = 0u; mine = 0u;
#pragma unroll
    for (unsigned j = 0; j < 16; ++j) { const unsigned c = xb_ld(&bar[XB_XCNT(j)]); sum += c; cnt += (c > 0u) ? 1u : 0u; mine = (j == x) ? c : mine; }
    if (sum == G) break;
    __builtin_amdgcn_s_sleep(1);
    if ((++sp & 255u) == 0u) { if (xb_ld(&bar[XB_TMO])) break; if (sp > XB_SPIN_CAP) { atomicAdd(&bar[XB_TMO], 1u); break; } }
  }
  nloc = mine > 0u ? mine : 1u; nx = cnt > 0u ? cnt : 1u;
}
DI void xcd_barrier(const XcdBarrier& b) {
  asm volatile("s_waitcnt vmcnt(0)" ::: "memory");
  __syncthreads();
  if (threadIdx.x == 0) {
    unsigned* bar = b.bar;
    __builtin_amdgcn_s_waitcnt(0);
    unsigned nloc = b.st[0], nx = b.st[1];
    if (nloc == 0u) { xcd_barrier_complete(bar, b.x, nloc, nx); b.st[0] = nloc; b.st[1] = nx; }
    const unsigned old = xb_add(&bar[XB_XSUB(b.x)], 1u);
    const unsigned gen = old / nloc;
    if (old + 1u == (gen + 1u) * nloc) {
      __builtin_amdgcn_fence(__ATOMIC_RELEASE, "agent");
      asm volatile("s_waitcnt vmcnt(0)" ::: "memory");
      const unsigned og = xb_add(&bar[XB_TOP], 1u);
      const unsigned tg = og / nx;
      if (og + 1u == (tg + 1u) * nx) xb_add(&bar[XB_TOPGEN], 1u);
      else XB_SPIN(xb_ld(&bar[XB_TOPGEN]) == tg, bar);
      __builtin_amdgcn_fence(__ATOMIC_ACQUIRE, "agent");
      xb_add(&bar[XB_XGEN(b.x)], 1u);
      asm volatile("s_waitcnt vmcnt(0)" ::: "memory");
    } else {
      XB_SPIN(xb_ld(&bar[XB_XGEN(b.x)]) == gen, bar);
      __builtin_amdgcn_fence(__ATOMIC_ACQUIRE, "agent");
      asm volatile("s_waitcnt vmcnt(0)" ::: "memory");
    }
  }
  __syncthreads();
}

namespace pg8 {
constexpr int BM = 256, BK = 64, HALF = 128, HTB = HALF * BK * 2, STAGE_BYTES = 8 * HTB, NXCD = 8, WGM = 8;
DI int lds_byte(int r, int c) { const int st = (r >> 4) * 2 + (c >> 5), rr = r & 15, cc = c & 31, ob = rr * 64 + cc * 2; return st * 1024 + (ob ^ (((ob >> 9) & 1) << 5)); }
DI void stage_rc(int b, int& R, int& C) { const int st = b / 1024, sb = b % 1024, swz = sb ^ (((sb >> 9) & 1) << 5); R = (st >> 1) * 16 + swz / 64; C = (st & 1) * 32 + (swz % 64) / 2; }
DI int perm32(int rho) { const int n = rho >> 4, i = rho & 15; return 8 * (i >> 2) + 4 * n + (i & 3); }
struct Unit { int pm, pn; };
struct Gemm { const bf16_t* A; const bf16_t* Bt; int M, N, K; };
struct StaticOrder {
  int nM, nN, nwg, G, c;
  DI void init(int M, int N, int G_, int c_) { nM = M / BM; nN = N / BM; nwg = nM * nN; G = G_; c = c_; }
  DI bool next(int i, Unit& u) const {
    const long L = (long)i * G + c; if (L >= nwg) return false;
    int wgid = (int)L; { const int q = nwg / NXCD, r = nwg % NXCD, xcd = wgid % NXCD, off = wgid / NXCD; wgid = (xcd < r ? xcd * (q + 1) : r * (q + 1) + (xcd - r) * q) + off; }
    const int nig = WGM * nN, gid = wgid / nig, fm = gid * WGM, gsz = (nM - fm) < WGM ? (nM - fm) : WGM;
    u.pm = fm + ((wgid % nig) % gsz); u.pn = (wgid % nig) / gsz; return true;
  }
};

template <class Epi>
DI void gemm_phase(LAS unsigned char* lds, const Gemm g, const StaticOrder& S, const Epi& E) {
  int tid_ = threadIdx.x; asm volatile("" : "+v"(tid_));
  const int tid = tid_, wid = __builtin_amdgcn_readfirstlane(tid >> 6), lane = tid & 63, wr = wid >> 2, wc = wid & 3, fr = lane & 15, fq = lane >> 4;
  const int K = g.K, nt = K / BK;
  unsigned voffA[2], voffB[2];
#pragma unroll
  for (int i = 0; i < 2; ++i) { int R, C; stage_rc(tid * 16 + i * 8192, R, C); const int Rb = Epi::PERM ? ((R & ~31) + perm32(R & 31)) : R;
    voffA[i] = (unsigned)(R * K + C) * 2u; voffB[i] = (unsigned)(Rb * K + C) * 2u; }
  const size_t kstep = (size_t)(BK * 2);
  const size_t hstep = (size_t)HALF * K * 2;
  const size_t tstep = 2 * hstep;
  const unsigned ldsw = (unsigned)wid * 1024u;
  const int aoff = lds_byte(wr * 64 + fr, fq * 8), boff = lds_byte(wc * 32 + fr, fq * 8);
#define PG8_SA(b, h) (((b) * 2 + (h)) * HTB)
#define PG8_SB(b, h) ((4 + (b) * 2 + (h)) * HTB)
#define PG8_STAGE(bufoff, gbase, voff) do { _Pragma("unroll") for (int _i = 0; _i < 2; ++_i) \
    __builtin_amdgcn_global_load_lds((const unsigned*)((const char*)(gbase) + (voff)[_i]), (LAS unsigned*)(lds + (bufoff) + ldsw + _i * 8192), 16, 0, 0); } while (0)
#define PG8_LDA(dst, b, h) do { _Pragma("unroll") for (int m = 0; m < 4; ++m) _Pragma("unroll") for (int k = 0; k < 2; ++k) dst[m][k] = *(const LAS bf16x8*)(lds + PG8_SA(b, h) + aoff + m * 2048 + k * 1024); } while (0)
#define PG8_LDB(dst, b, h) do { _Pragma("unroll") for (int n = 0; n < 2; ++n) _Pragma("unroll") for (int k = 0; k < 2; ++k) dst[n][k] = *(const LAS bf16x8*)(lds + PG8_SB(b, h) + boff + n * 2048 + k * 1024); } while (0)
#define PG8_MMA(ai, bj, At, Bt) do { __builtin_amdgcn_s_setprio(1); _Pragma("unroll") for (int m = 0; m < 4; ++m) _Pragma("unroll") for (int n = 0; n < 2; ++n) _Pragma("unroll") for (int k = 0; k < 2; ++k) \
    acc[ai][bj][m][n] = __builtin_amdgcn_mfma_f32_16x16x32_bf16(Bt[n][k], At[m][k], acc[ai][bj][m][n], 0, 0, 0); __builtin_amdgcn_s_setprio(0); } while (0)
#define PG8_WAIT_V(n) asm volatile("s_waitcnt vmcnt(" #n ")" ::: "memory")
#define PG8_WAIT_L(n) asm volatile("s_waitcnt lgkmcnt(" #n ")" ::: "memory")
#define PG8_BAR __builtin_amdgcn_s_barrier()
#define PG8_SCHED __builtin_amdgcn_sched_barrier(0)
  Unit cur, nxt; int ui = 0;
  if (!S.next(0, cur)) return;
  f32x4 acc[2][2][4][2];
#pragma unroll
  for (int a = 0; a < 2; ++a)
#pragma unroll
    for (int b = 0; b < 2; ++b)
#pragma unroll
      for (int m = 0; m < 4; ++m)
#pragma unroll
        for (int n = 0; n < 2; ++n) acc[a][b][m][n] = (f32x4){0.f, 0.f, 0.f, 0.f};
  bf16x8 At[4][2], B0[2][2], B1[2][2];
  const char* cA = (const char*)g.A + (size_t)cur.pm * tstep; const char* cB = (const char*)g.Bt + (size_t)cur.pn * tstep;
  PG8_STAGE(PG8_SB(0, 0), cB, voffB); PG8_STAGE(PG8_SA(0, 0), cA, voffA); PG8_STAGE(PG8_SB(0, 1), cB + hstep, voffB); PG8_STAGE(PG8_SA(0, 1), cA + hstep, voffA);
  if (wr == 1) PG8_BAR;
  PG8_WAIT_V(4); PG8_BAR;
  PG8_STAGE(PG8_SB(1, 0), cB + kstep, voffB); PG8_STAGE(PG8_SA(1, 0), cA + kstep, voffA); PG8_STAGE(PG8_SB(1, 1), cB + hstep + kstep, voffB);
  PG8_WAIT_V(6); PG8_BAR;
  for (;;) {
    const bool has_next = S.next(ui + 1, nxt);
    const char* nA = has_next ? (const char*)g.A + (size_t)nxt.pm * tstep : cA; const char* nB = has_next ? (const char*)g.Bt + (size_t)nxt.pn * tstep : cB;
    for (int t = 0; t < nt; t += 2) {
      const bool last = (t == nt - 2);
      const char* a1 = cA + (size_t)(t + 1) * kstep;
      const char* a2 = last ? nA : cA + (size_t)(t + 2) * kstep; const char* b2 = last ? nB : cB + (size_t)(t + 2) * kstep;
      const char* a3 = a2 + kstep; const char* b3 = b2 + kstep;
      PG8_LDB(B0, 0, 0); PG8_SCHED; PG8_LDA(At, 0, 0); PG8_STAGE(PG8_SA(1, 1), a1 + hstep, voffA);
      PG8_WAIT_L(8); PG8_BAR; PG8_WAIT_L(0); PG8_MMA(0, 0, At, B0); PG8_BAR; PG8_SCHED;
      PG8_LDB(B1, 0, 1); PG8_STAGE(PG8_SB(0, 0), b2, voffB);
      PG8_BAR; PG8_WAIT_L(0); PG8_MMA(0, 1, At, B1); PG8_BAR;
      PG8_LDA(At, 0, 1); PG8_STAGE(PG8_SA(0, 0), a2, voffA);
      PG8_BAR; PG8_WAIT_L(0); PG8_MMA(1, 0, At, B0); PG8_BAR; PG8_SCHED;
      PG8_STAGE(PG8_SB(0, 1), b2 + hstep, voffB);
      PG8_WAIT_V(6); PG8_BAR; PG8_MMA(1, 1, At, B1); PG8_BAR;
      PG8_LDB(B0, 1, 0); PG8_SCHED; PG8_LDA(At, 1, 0); PG8_STAGE(PG8_SA(0, 1), a2 + hstep, voffA);
      PG8_WAIT_L(8); PG8_BAR; PG8_WAIT_L(0); PG8_MMA(0, 0, At, B0); PG8_BAR; PG8_SCHED;
      PG8_LDB(B1, 1, 1); PG8_STAGE(PG8_SB(1, 0), b3, voffB);
      PG8_BAR; PG8_WAIT_L(0); PG8_MMA(0, 1, At, B1); PG8_BAR;
      PG8_LDA(At, 1, 1); PG8_STAGE(PG8_SA(1, 0), a3, voffA);
      PG8_BAR; PG8_WAIT_L(0); PG8_MMA(1, 0, At, B0); PG8_BAR; PG8_SCHED;
      PG8_STAGE(PG8_SB(1, 1), b3 + hstep, voffB);
      PG8_WAIT_V(6); PG8_BAR; PG8_MMA(1, 1, At, B1); PG8_BAR;
    }
    E(acc, cur, wr, wc, fr, fq);
    if (!has_next) break;
#pragma unroll
    for (int a = 0; a < 2; ++a)
#pragma unroll
      for (int b = 0; b < 2; ++b)
#pragma unroll
        for (int m = 0; m < 4; ++m)
#pragma unroll
          for (int n = 0; n < 2; ++n) acc[a][b][m][n] = (f32x4){0.f, 0.f, 0.f, 0.f};
    cur = nxt; cA = nA; cB = nB; ++ui;
  }
  PG8_WAIT_V(0);
  if (wr == 0) PG8_BAR;
  PG8_BAR;
#undef PG8_SA
#undef PG8_SB
#undef PG8_STAGE
#undef PG8_LDA
#undef PG8_LDB
#undef PG8_MMA
#undef PG8_WAIT_V
#undef PG8_WAIT_L
#undef PG8_BAR
#undef PG8_SCHED
}
}

struct EpiU {
  static constexpr bool PERM = true;
  bf16_t* U; const float* qg; const float* kg;
  DI void operator()(const f32x4 (&acc)[2][2][4][2], const pg8::Unit& u, int wr, int wc, int fr, int fq) const {
    const int row0 = u.pm * 256 + wr * 64 + fr, col0 = u.pn * 256 + wc * 64 + 8 * fq;
    const bool nrm = u.pn < 4;
    f32x4 gv[2][2];
#pragma unroll
    for (int bj = 0; bj < 2; ++bj)
#pragma unroll
      for (int n = 0; n < 2; ++n) gv[bj][n] = (f32x4){1.f, 1.f, 1.f, 1.f};
    if (nrm) {
      const float* gp = (u.pn < 2) ? qg : kg; const float sc = (u.pn < 2) ? (LOG2E * 0.125f) : 1.0f;
#pragma unroll
      for (int bj = 0; bj < 2; ++bj)
#pragma unroll
        for (int n = 0; n < 2; ++n) { gv[bj][n] = *(const f32x4*)(gp + 32 * bj + 8 * fq + 4 * n); gv[bj][n] *= sc; }
    }
#pragma unroll
    for (int ai = 0; ai < 2; ++ai)
#pragma unroll
      for (int m = 0; m < 4; ++m) {
        bf16_t* rowp = U + (size_t)(row0 + ai * 128 + m * 16) * NU + col0;
        float rs = 1.0f;
        if (nrm) {
          float ss = 0.f;
#pragma unroll
          for (int bj = 0; bj < 2; ++bj)
#pragma unroll
            for (int n = 0; n < 2; ++n)
#pragma unroll
              for (int i = 0; i < 4; ++i) ss += acc[ai][bj][m][n][i] * acc[ai][bj][m][n][i];
          ss += __shfl_xor(ss, 16); ss += __shfl_xor(ss, 32);
          rs = rsqrtf(ss * (1.0f / 64.0f) + EPS);
        }
#pragma unroll
        for (int bj = 0; bj < 2; ++bj) {
          f32x4 v0 = acc[ai][bj][m][0], v1 = acc[ai][bj][m][1];
          v0 = v0 * rs * gv[bj][0]; v1 = v1 * rs * gv[bj][1];
          u32x4 o; o[0] = pack2(v0[0], v0[1]); o[1] = pack2(v0[2], v0[3]); o[2] = pack2(v1[0], v1[1]); o[3] = pack2(v1[2], v1[3]);
          *(u32x4*)(rowp + 32 * bj) = o;
        }
      }
  }
};

struct EpiOut {
  static constexpr bool PERM = false;
  float* O; const float* X; const float* mod;
  DI void operator()(const f32x4 (&acc)[2][2][4][2], const pg8::Unit& u, int wr, int wc, int fr, int fq) const {
    const int row0 = u.pm * 256 + wr * 64 + fr, col0 = u.pn * 256 + wc * 32 + 4 * fq;
    const int b = (u.pm * 256) >> 12;
    f32x4 gv[2][2];
#pragma unroll
    for (int bj = 0; bj < 2; ++bj)
#pragma unroll
      for (int n = 0; n < 2; ++n) gv[bj][n] = *(const f32x4*)(mod + (size_t)b * 3072 + 2048 + col0 + bj * 128 + n * 16);
#pragma unroll
    for (int ai = 0; ai < 2; ++ai) {
      f32x4 xv[4][2][2];
#pragma unroll
      for (int m = 0; m < 4; ++m)
#pragma unroll
        for (int bj = 0; bj < 2; ++bj)
#pragma unroll
          for (int n = 0; n < 2; ++n) xv[m][bj][n] = *(const f32x4*)(X + (size_t)(row0 + ai * 128 + m * 16) * DM + col0 + bj * 128 + n * 16);
      __builtin_amdgcn_sched_barrier(0);
#pragma unroll
      for (int m = 0; m < 4; ++m)
#pragma unroll
        for (int bj = 0; bj < 2; ++bj)
#pragma unroll
          for (int n = 0; n < 2; ++n) *(f32x4*)(O + (size_t)(row0 + ai * 128 + m * 16) * DM + col0 + bj * 128 + n * 16) = xv[m][bj][n] + gv[bj][n] * acc[ai][bj][m][n];
      __builtin_amdgcn_sched_barrier(0);
    }
  }
};

DI void phase_a(const Params& p, unsigned char* lds) {
  const int tid = threadIdx.x;
  float* sc = (float*)lds;
  float* red = sc + 16 * 1024;
  if (blockIdx.x < 192) {
    for (int i = tid; i < 16 * 1024; i += 512) sc[i] = siluf(p.c[i]);
    __syncthreads();
    for (int item = blockIdx.x; item < 192; item += gridDim.x) {
      const int n0 = item * 16, ks = tid >> 4, col = tid & 15;
      float acc[16];
#pragma unroll
      for (int b = 0; b < 16; ++b) acc[b] = 0.f;
      for (int kk = 0; kk < 32; ++kk) {
        const int k = kk * 32 + ks;
        const float w = p.w_ada[(size_t)k * 3072 + n0 + col];
#pragma unroll
        for (int b = 0; b < 16; ++b) acc[b] += sc[b * 1024 + k] * w;
      }
#pragma unroll
      for (int b = 0; b < 16; ++b) red[(ks * 16 + b) * 16 + col] = acc[b];
      __syncthreads();
      if (tid < 256) {
        const int b = tid >> 4; float s = 0.f;
        for (int q = 0; q < 32; ++q) s += red[(q * 16 + b) * 16 + col];
        p.mod[b * 3072 + n0 + col] = s + p.b_ada[n0 + col];
      }
      __syncthreads();
    }
  }
}
DI void weight_transposes(const Params& p, float* tile) {
  const int tid = threadIdx.x;
  for (int tt = blockIdx.x; tt < 288 + 64; tt += gridDim.x) {
    const bool first = tt < 288;
    const float* src = first ? p.w_in : p.w_out; const int ld = first ? WIN_LD : DM;
    const int t2 = first ? tt : tt - 288, ntile = first ? 72 : 16;
    const int k0 = (t2 / ntile) * 256, n0 = (t2 % ntile) * 64;
    {
      const int kk = tid >> 4, n4 = (tid & 15) * 4;
      f32x4 v[8];
#pragma unroll
      for (int i = 0; i < 8; ++i) v[i] = *(const f32x4*)(src + (size_t)(k0 + kk + 32 * i) * ld + n0 + n4);
#pragma unroll
      for (int i = 0; i < 8; ++i) *(f32x4*)(tile + (kk + 32 * i) * 68 + n4) = v[i];
    }
    __syncthreads();
    {
      const int nn = tid >> 3, k32 = (tid & 7) * 32;
      const int n = n0 + nn;
      int drow = n;
      if (first) { const int cu = n & 255; drow = (n & ~255) + 128 * ((cu >> 5) & 1) + 32 * (cu >> 6) + (cu & 31); }
      bf16_t* dst = (first ? p.w1t : p.w2t) + (size_t)drow * 1024 + k0 + k32;
#pragma unroll
      for (int q = 0; q < 4; ++q) {
        u32x4 o;
#pragma unroll
        for (int j = 0; j < 4; ++j) o[j] = pack2(tile[(k32 + 8 * q + 2 * j) * 68 + nn], tile[(k32 + 8 * q + 2 * j + 1) * 68 + nn]);
        *(u32x4*)(dst + 8 * q) = o;
      }
    }
    __syncthreads();
  }
}

DI void phase_b(const Params& p, unsigned char* lds) {
  int tid_ = threadIdx.x; asm volatile("" : "+v"(tid_));
  const int tid = tid_, wid = tid >> 6, lane = tid & 63;
  f32x4 wlo[4][4], whi[4][4];
#pragma unroll
  for (int i = 0; i < 4; ++i)
#pragma unroll
    for (int kk = 0; kk < 4; ++kk) {
      const float* wp = p.w_in + (size_t)(4 * lane + 256 * i + kk) * WIN_LD + 4608;
      wlo[i][kk] = *(const f32x4*)(wp); whi[i][kk] = *(const f32x4*)(wp + 4);
    }
  const int rpb = (NTOK + gridDim.x - 1) / gridDim.x;
  const int rbeg = blockIdx.x * rpb, rend = min(NTOK, rbeg + rpb);
  int curb = -1;
  f32x4 A[4], Bs[4];
#pragma unroll
  for (int i = 0; i < 4; ++i) { A[i] = (f32x4){0.f, 0.f, 0.f, 0.f}; Bs[i] = A[i]; }
  f32x4 xn[4];
#pragma unroll
  for (int i = 0; i < 4; ++i) xn[i] = (f32x4){0.f, 0.f, 0.f, 0.f};
  if (rbeg + wid < rend) {
#pragma unroll
    for (int i = 0; i < 4; ++i) xn[i] = *(const f32x4*)(p.x + (size_t)(rbeg + wid) * DM + 4 * lane + 256 * i);
  }
  const bool b5 = (lane & 32) != 0, b4 = (lane & 16) != 0, b3 = (lane & 8) != 0;
  const int gj = (b5 ? 4 : 0) + (b4 ? 2 : 0) + (b3 ? 1 : 0);
  const float gbias = p.b_gates[gj];
  for (int row = rbeg + wid; row < rend; row += 8) {
    const int b = row >> 12;
    if (b != curb) {
      curb = b;
#pragma unroll
      for (int i = 0; i < 4; ++i) {
        const int k = 4 * lane + 256 * i;
        const f32x4 g = *(const f32x4*)(p.norm_gain + k), s = *(const f32x4*)(p.mod + b * 3072 + 1024 + k);
        A[i] = g * (s + 1.0f); Bs[i] = *(const f32x4*)(p.mod + b * 3072 + k);
      }
    }
    f32x4 xv[4]; float ss = 0.f;
#pragma unroll
    for (int i = 0; i < 4; ++i) { xv[i] = xn[i]; ss += xv[i][0] * xv[i][0] + xv[i][1] * xv[i][1] + xv[i][2] * xv[i][2] + xv[i][3] * xv[i][3]; }
    if (row + 8 < rend) {
#pragma unroll
      for (int i = 0; i < 4; ++i) xn[i] = __builtin_nontemporal_load((const f32x4*)(p.x + (size_t)(row + 8) * DM + 4 * lane + 256 * i));
    }
    ss = wave_sum(ss);
    const float r = rsqrtf(ss * (1.0f / 1024.0f) + EPS);
    f32x4 glo = (f32x4){0.f, 0.f, 0.f, 0.f}, ghi = glo;
#pragma unroll
    for (int i = 0; i < 4; ++i) {
      const f32x4 h = xv[i] * r * A[i] + Bs[i];
      u32x2 o; o[0] = pack2(h[0], h[1]); o[1] = pack2(h[2], h[3]);
      *(u32x2*)(p.hn + (size_t)row * DM + 4 * lane + 256 * i) = o;
#pragma unroll
      for (int kk = 0; kk < 4; ++kk) { glo += wlo[i][kk] * h[kk]; ghi += whi[i][kk] * h[kk]; }
    }
    f32x4 k4, s4;
#pragma unroll
    for (int j = 0; j < 4; ++j) { k4[j] = b5 ? ghi[j] : glo[j]; s4[j] = b5 ? glo[j] : ghi[j]; }
#pragma unroll
    for (int j = 0; j < 4; ++j) k4[j] += __shfl_xor(s4[j], 32);
    float k2[2], s2[2];
#pragma unroll
    for (int j = 0; j < 2; ++j) { k2[j] = b4 ? k4[2 + j] : k4[j]; s2[j] = b4 ? k4[j] : k4[2 + j]; }
#pragma unroll
    for (int j = 0; j < 2; ++j) k2[j] += __shfl_xor(s2[j], 16);
    float v = b3 ? k2[1] : k2[0];
    const float sv = b3 ? k2[0] : k2[1];
    v += __shfl_xor(sv, 8);
    v += __shfl_xor(v, 4); v += __shfl_xor(v, 2); v += __shfl_xor(v, 1);
    if ((lane & 7) == 0) {
      v += gbias;
      if (gj >= 4) v = fminf(v, 0.f) - log1pf(__expf(-fabsf(v)));
      p.gates[(size_t)row * 8 + gj] = v;
    }
  }
  __syncthreads();
  weight_transposes(p, (float*)lds);
}

DI int crow(int reg, int h) { return (reg & 3) + 8 * (reg >> 2) + 4 * h; }
constexpr float SB_EXIT = -26.0f;

DI void sb_wave(const Params& p, int b, int h, int qt, bf16_t* wl) {
  int tid_ = threadIdx.x; asm volatile("" : "+v"(tid_));
  const int lane = tid_ & 63, r = lane & 31, hh = lane >> 5;
  const bf16_t* ub = p.u + (size_t)b * SEQ * NU;
  const int t0 = qt * 32;
  bf16x8 qf[4];
#pragma unroll
  for (int s = 0; s < 4; ++s) qf[s] = *(const bf16x8*)(ub + (size_t)(t0 + r) * NU + h * 64 + 16 * s + 8 * hh);
  bf16x8 mf[2];
#pragma unroll
  for (int s = 0; s < 2; ++s)
#pragma unroll
    for (int j = 0; j < 8; ++j) mf[s][j] = (crow(8 * s + j, hh) > r) ? (short)0x3F80 : (short)0;
  f32x16 o0, o1;
#pragma unroll
  for (int i = 0; i < 16; ++i) { o0[i] = 0.f; o1[i] = 0.f; }
  float carry = 0.f;
  const unsigned vtb = (unsigned)(size_t)wl + (unsigned)(((4 * hh + ((lane & 15) >> 2)) * 72 + 16 * ((lane >> 4) & 1) + 4 * (lane & 3)) * 2);
  const size_t trow = (size_t)b * SEQ + t0 + r;
  u32x2 zg[2][4];
  {
    const bf16_t* zp = p.u + trow * NU + 1536 + h * 64;
#pragma unroll
    for (int et = 0; et < 2; ++et)
#pragma unroll
      for (int g = 0; g < 4; ++g) zg[et][g] = *(const u32x2*)(zp + 32 * et + 8 * g + 4 * hh);
  }
  bf16x8 kn[4], vn[4];
  {
    const bf16_t* kp = ub + (size_t)(t0 + r) * NU + 512 + h * 64 + 8 * hh;
    const bf16_t* vp = ub + (size_t)(t0 + (lane >> 1)) * NU + 1024 + h * 64 + (lane & 1) * 32;
#pragma unroll
    for (int s = 0; s < 4; ++s) { kn[s] = *(const bf16x8*)(kp + 16 * s); vn[s] = *(const bf16x8*)(vp + 8 * s); }
  }
  for (int tile = qt; tile >= 0; --tile) {
    bf16x8 kf[4];
    {
      bf16x8 vv[4];
#pragma unroll
      for (int s = 0; s < 4; ++s) { kf[s] = kn[s]; vv[s] = vn[s]; }
      if (tile > 0) {
        const int s1 = (tile - 1) * 32;
        const bf16_t* kp = ub + (size_t)(s1 + r) * NU + 512 + h * 64 + 8 * hh;
        const bf16_t* vp = ub + (size_t)(s1 + (lane >> 1)) * NU + 1024 + h * 64 + (lane & 1) * 32;
#pragma unroll
        for (int s = 0; s < 4; ++s) { kn[s] = *(const bf16x8*)(kp + 16 * s); vn[s] = *(const bf16x8*)(vp + 8 * s); }
      }
      asm volatile("s_waitcnt lgkmcnt(0)" ::: "memory");
      __builtin_amdgcn_wave_barrier();
#pragma unroll
      for (int c4 = 0; c4 < 4; ++c4) *(bf16x8*)(wl + (lane >> 1) * 72 + (lane & 1) * 32 + c4 * 8) = vv[c4];
    }
    asm volatile("s_waitcnt lgkmcnt(0)" ::: "memory");
    __builtin_amdgcn_wave_barrier();
    s16x4 vt[2][2][2];
#pragma unroll
    for (int et = 0; et < 2; ++et)
#pragma unroll
      for (int s = 0; s < 2; ++s)
#pragma unroll
        for (int hf = 0; hf < 2; ++hf)
          asm volatile("ds_read_b64_tr_b16 %0, %1 offset:%2" : "=&v"(vt[et][s][hf]) : "v"(vtb), "i"((16 * s + 8 * hf) * 144 + 64 * et) : "memory");
    f32x16 S;
#pragma unroll
    for (int i = 0; i < 16; ++i) S[i] = 0.f;
#pragma unroll
    for (int s = 0; s < 4; ++s) S = __builtin_amdgcn_mfma_f32_32x32x16_bf16(kf[s], qf[s], S, 0, 0, 0);
    const bool diag = (tile == qt);
    f32x16 cin; float lm[16]; float tot = 0.f;
#pragma unroll
    for (int i = 0; i < 16; ++i) {
      const float z = S[i];
      const float e = __builtin_amdgcn_exp2f(z);
      const float sp = __builtin_amdgcn_logf(1.0f + e);
      const bool valid = !diag || (crow(i, hh) < r);
      lm[i] = valid ? -sp : 0.f;
      cin[i] = z - sp + carry;
      tot += lm[i];
    }
    tot += __shfl_xor(tot, 32);
    bf16x8 lf[2];
#pragma unroll
    for (int s = 0; s < 2; ++s) {
      u32x4 pk;
#pragma unroll
      for (int j = 0; j < 4; ++j) pk[j] = pack2(lm[8 * s + 2 * j], lm[8 * s + 2 * j + 1]);
      lf[s] = __builtin_bit_cast(bf16x8, pk);
    }
    cin = __builtin_amdgcn_mfma_f32_32x32x16_bf16(mf[0], lf[0], cin, 0, 0, 0);
    cin = __builtin_amdgcn_mfma_f32_32x32x16_bf16(mf[1], lf[1], cin, 0, 0, 0);
    bf16x8 pf[2];
#pragma unroll
    for (int s = 0; s < 2; ++s) {
      u32x4 pk;
#pragma unroll
      for (int j = 0; j < 4; ++j) {
        const int i0 = 8 * s + 2 * j, i1 = i0 + 1;
        const bool v0 = !diag || (crow(i0, hh) < r), v1 = !diag || (crow(i1, hh) < r);
        const float a0 = v0 ? __builtin_amdgcn_exp2f(cin[i0]) : 0.f, a1 = v1 ? __builtin_amdgcn_exp2f(cin[i1]) : 0.f;
        pk[j] = pack2(a0, a1);
      }
      pf[s] = __builtin_bit_cast(bf16x8, pk);
    }
    carry += tot;
    asm volatile("s_waitcnt lgkmcnt(0)" : "+v"(vt[0][0][0]), "+v"(vt[0][0][1]), "+v"(vt[0][1][0]), "+v"(vt[0][1][1]), "+v"(vt[1][0][0]), "+v"(vt[1][0][1]), "+v"(vt[1][1][0]), "+v"(vt[1][1][1]) :: "memory");
#pragma unroll
    for (int s = 0; s < 2; ++s) {
      const bf16x8 va = __builtin_shufflevector(vt[0][s][0], vt[0][s][1], 0, 1, 2, 3, 4, 5, 6, 7);
      const bf16x8 vb2 = __builtin_shufflevector(vt[1][s][0], vt[1][s][1], 0, 1, 2, 3, 4, 5, 6, 7);
      o0 = __builtin_amdgcn_mfma_f32_32x32x16_bf16(va, pf[s], o0, 0, 0, 0);
      o1 = __builtin_amdgcn_mfma_f32_32x32x16_bf16(vb2, pf[s], o1, 0, 0, 0);
    }
    if (__ballot(carry > SB_EXIT) == 0ull) break;
  }
  bf16_t* yp = p.y + trow * DM + h * 64;
#pragma unroll
  for (int et = 0; et < 2; ++et)
#pragma unroll
    for (int g = 0; g < 4; ++g) {
      const int e = 32 * et + 8 * g + 4 * hh;
      const u32x2 zz = zg[et][g];
      float v[4];
#pragma unroll
      for (int i = 0; i < 4; ++i) v[i] = (et == 0) ? o0[4 * g + i] : o1[4 * g + i];
      u32x2 ov;
      ov[0] = pack2(v[0] * siluf(bflo(zz[0])), v[1] * siluf(bfhi(zz[0])));
      ov[1] = pack2(v[2] * siluf(bflo(zz[1])), v[3] * siluf(bfhi(zz[1])));
      *(u32x2*)(yp + e) = ov;
    }
}

constexpr int ML_QS = 0, ML_KS = 17408, ML_NUM = 0, ML_KWT = 34816, ML_VT = 53248, ML_SC = 73984, ML_CT = 83200, ML_SM = 122368, ML_CW = 125568, ML_SCN = 131072;
constexpr int QST = 136, KST = 72, NST = 132;

struct MlRegs { unsigned rq[11], rk[11], rv[8]; float gi_raw, gf_raw; };

template <int MODE>
DI void ml_load_chunk(MlRegs& R, const bf16_t* ub, const bf16_t* kt, const float* gb, int c, int h, int wid, int lane, int erow, int epart) {
  const int base = c * 64 + 8 * wid;
#pragma unroll
  for (int j = 0; j < 11; ++j) {
    const int t = base - 3 + j;
    if (MODE == 1) {
      R.rq[j] = (t >= 0) ? *(const unsigned*)(ub + (size_t)t * NU + 2048 + h * 128 + 2 * lane) : 0u;
      if (j < 8) R.rk[j] = *(const unsigned*)(kt + (size_t)(base + j) * 512 + h * 128 + 2 * lane);
    } else {
      R.rk[j] = (t >= 0) ? *(const unsigned*)(ub + (size_t)t * NU + 2560 + h * 128 + 2 * lane) : 0u;
    }
  }
#pragma unroll
  for (int j = 0; j < 8; ++j) R.rv[j] = *(const unsigned*)(ub + (size_t)(base + j) * NU + 3072 + h * 128 + 2 * lane);
  if (wid == 0) { R.gi_raw = gb[(size_t)(c * 64 + lane) * 8 + h]; R.gf_raw = gb[(size_t)(c * 64 + lane) * 8 + 4 + h]; }
}

template <int MODE>
DI void ml_super(const Params& p, int b, int h, int J, unsigned char* lds) {
  int tid_ = threadIdx.x; asm volatile("" : "+v"(tid_));
  const int tid = tid_, wid = tid >> 6, lane = tid & 63, r16 = lane & 15, q4 = lane >> 4;
  bf16_t* qs = (bf16_t*)(lds + ML_QS); bf16_t* ks = (bf16_t*)(lds + ML_KS); float* num = (float*)(lds + ML_NUM);
  bf16_t* kwT = (bf16_t*)(lds + ML_KWT); bf16_t* vT = (bf16_t*)(lds + ML_VT); bf16_t* scm = (bf16_t*)(lds + ML_SC); bf16_t* CT = (bf16_t*)(lds + ML_CT);
  const bf16_t* ub = p.u + (size_t)b * SEQ * NU;
  const float* gb = p.gates + (size_t)b * SEQ * 8;
  float* s_cw = (float*)(lds + ML_CW);
  __syncthreads();
  for (int i = tid; i < 1280; i += 512) { const int j = i >> 8, qk = (i >> 7) & 1, ch = i & 127; s_cw[i] = (j < 4) ? p.conv_w[j * 1024 + qk * 512 + h * 128 + ch] : p.conv_b[qk * 512 + h * 128 + ch]; }
  for (int i = tid; i < 144 * QST / 2; i += 512) ((unsigned*)CT)[i] = 0u;
  for (int i = tid; i < 16 * KST; i += 512) vT[128 * KST + i] = (i < KST) ? (bf16_t)0x3F80 : (bf16_t)0;
  __syncthreads();
  const int c0 = J * 16, item = ((b * 4 + h) * 4 + J);
  f32x4 Cst[9];
#pragma unroll
  for (int e = 0; e < 9; ++e) Cst[e] = (f32x4){0.f, 0.f, 0.f, 0.f};
  if (MODE == 1) {
    for (int Jp = 0; Jp < J; ++Jp) {
      const float* li = p.Lst + (size_t)(item - J + Jp) * (9 * 512 * 4);
      const float G = p.gch[item - J + Jp];
#pragma unroll
      for (int et = 0; et < 9; ++et) Cst[et] = Cst[et] * G + *(const f32x4*)(li + (size_t)(et * 512 + tid) * 4);
    }
#pragma unroll
    for (int et = 0; et < 9; ++et) {
      u32x2 o; o[0] = pack2(Cst[et][0], Cst[et][1]); o[1] = pack2(Cst[et][2], Cst[et][3]);
      *(u32x2*)(CT + (16 * et + r16) * QST + 16 * wid + 4 * q4) = o;
    }
  }
  float* scn = (float*)(lds + ML_SCN);
  {
    float* s_sum = (float*)(lds + ML_KWT);
    float bcv[2], av[2], cmv[2];
    for (int cc = wid; cc < c0; cc += 8) {
      float bc = gb[(size_t)(cc * 64 + lane) * 8 + 4 + h]; const float gi = gb[(size_t)(cc * 64 + lane) * 8 + h];
#pragma unroll
      for (int o = 1; o < 64; o <<= 1) { const float t = __shfl_up(bc, o); if (lane >= o) bc += t; }
      float am = gi - bc;
#pragma unroll
      for (int o = 32; o >= 1; o >>= 1) am = fmaxf(am, __shfl_xor(am, o));
      if (lane == 63) { s_sum[2 * cc] = bc; s_sum[2 * cc + 1] = am; }
    }
#pragma unroll
    for (int q = 0; q < 2; ++q) {
      const int cc = c0 + 2 * wid + q;
      float bc = gb[(size_t)(cc * 64 + lane) * 8 + 4 + h]; const float gi = gb[(size_t)(cc * 64 + lane) * 8 + h];
#pragma unroll
      for (int o = 1; o < 64; o <<= 1) { const float t = __shfl_up(bc, o); if (lane >= o) bc += t; }
      const float a = gi - bc;
      float cm = a;
#pragma unroll
      for (int o = 1; o < 64; o <<= 1) { const float t = __shfl_up(cm, o); if (lane >= o) cm = fmaxf(cm, t); }
      bcv[q] = bc; av[q] = a; cmv[q] = cm;
      if (lane == 63) { s_sum[2 * cc] = bc; s_sum[2 * cc + 1] = cm; }
    }
    __syncthreads();
    float m_prev = 0.f;
    for (int cc = 0; cc < c0 + 2 * wid; ++cc) m_prev = s_sum[2 * cc] + fmaxf(m_prev, s_sum[2 * cc + 1]);
#pragma unroll
    for (int q = 0; q < 2; ++q) {
      float* sm = scn + (2 * wid + q) * 448;
      const float M = fmaxf(m_prev, cmv[q]);
      const float M63 = __shfl(M, 63), bl = __shfl(bcv[q], 63);
      sm[lane] = av[q] * LOG2E; sm[64 + lane] = M * LOG2E; sm[128 + lane] = __expf(m_prev - M); sm[192 + lane] = __expf(-(bcv[q] + M)); sm[256 + lane] = __expf(av[q] - M63);
      if (lane == 0) sm[384] = __expf(m_prev - M63);
      m_prev = bl + M63;
    }
    __syncthreads();
  }
  const int erow = tid >> 3, epart = tid & 7;
  MlRegs R;
  const bf16_t* kt = p.hn + (size_t)b * SEQ * 512;
  ml_load_chunk<MODE>(R, ub, kt, gb, c0, h, wid, lane, erow, epart);
  for (int c = c0; c < c0 + 16; ++c) {
    float* sm = scn + (c - c0) * 448;
    float* s_a2 = sm, *s_M2 = sm + 64, *s_gi = sm + 128, *s_en = sm + 192, *s_w = sm + 256, *s_den = sm + 320, *s_misc = sm + 384;
    __syncthreads();
    {
      float wv[8];
#pragma unroll
      for (int j = 0; j < 8; ++j) wv[j] = s_w[8 * wid + j];
      float kq[8][2];
      u32x4 kw0, kw1, v0, v1;
      f32x2 cwq[5], cwk[5];
#pragma unroll
      for (int t = 0; t < 5; ++t) { cwq[t] = *(const f32x2*)(s_cw + t * 256 + 2 * lane); cwk[t] = *(const f32x2*)(s_cw + t * 256 + 128 + 2 * lane); }
#pragma unroll
      for (int j = 0; j < 8; ++j) {
        float aq0 = cwq[4][0], aq1 = cwq[4][1], ak0 = cwk[4][0], ak1 = cwk[4][1];
#pragma unroll
        for (int t = 0; t < 4; ++t) {
          if (MODE == 1) { aq0 += cwq[t][0] * bflo(R.rq[j + t]); aq1 += cwq[t][1] * bfhi(R.rq[j + t]); }
          else { ak0 += cwk[t][0] * bflo(R.rk[j + t]); ak1 += cwk[t][1] * bfhi(R.rk[j + t]); }
        }
        float sk0, sk1;
        if (MODE == 1) { sk0 = bflo(R.rk[j]); sk1 = bfhi(R.rk[j]); }
        else {
          sk0 = siluf(ak0); sk1 = siluf(ak1);
          const unsigned pk = pack2(sk0, sk1);
          *(unsigned*)(const_cast<bf16_t*>(kt) + (size_t)(c * 64 + 8 * wid + j) * 512 + h * 128 + 2 * lane) = pk;
          sk0 = bflo(pk); sk1 = bfhi(pk);
        }
        if (MODE == 1) {
          const float sq0 = siluf(aq0) * 0.08838834764831845f, sq1 = siluf(aq1) * 0.08838834764831845f;
          *(unsigned*)(qs + (8 * wid + j) * QST + 2 * lane) = pack2(sq0, sq1);
          *(unsigned*)(ks + (8 * wid + j) * QST + 2 * lane) = pack2(sk0, sk1);
        }
        kq[j][0] = sk0 * wv[j]; kq[j][1] = sk1 * wv[j];
      }
#pragma unroll
      for (int j = 0; j < 4; ++j) {
        kw0[j] = pack2(kq[2 * j][0], kq[2 * j + 1][0]); kw1[j] = pack2(kq[2 * j][1], kq[2 * j + 1][1]);
        v0[j] = (R.rv[2 * j] & 0xFFFFu) | (R.rv[2 * j + 1] << 16); v1[j] = (R.rv[2 * j] >> 16) | (R.rv[2 * j + 1] & 0xFFFF0000u);
      }
      *(u32x4*)(kwT + (2 * lane) * KST + 8 * wid) = kw0; *(u32x4*)(kwT + (2 * lane + 1) * KST + 8 * wid) = kw1;
      *(u32x4*)(vT + (2 * lane) * KST + 8 * wid) = v0;   *(u32x4*)(vT + (2 * lane + 1) * KST + 8 * wid) = v1;
    }
    __builtin_amdgcn_sched_barrier(0);
    if (c + 1 < c0 + 16) ml_load_chunk<MODE>(R, ub, kt, gb, c + 1, h, wid, lane, erow, epart);
    __syncthreads();
    if constexpr (MODE == 1) {
    const bf16_t* op = ub + (size_t)(c * 64 + erow) * NU + 3584 + h * 128 + 16 * epart;
    const u32x4 o0 = *(const u32x4*)(op), o1 = *(const u32x4*)(op + 8), z0 = *(const u32x4*)(op + 512), z1 = *(const u32x4*)(op + 520);
    {
#pragma unroll
      for (int q = 0; q < 2; ++q) {
        const int idx = 2 * wid + q, st = idx >> 2, lt = idx & 3;
        f32x4 acc = (f32x4){0.f, 0.f, 0.f, 0.f};
        if (st <= lt) {
#pragma unroll
          for (int kk = 0; kk < 4; ++kk) {
            const bf16x8 af = *(const bf16x8*)(ks + (16 * st + r16) * QST + 32 * kk + 8 * q4);
            const bf16x8 bfm = *(const bf16x8*)(qs + (16 * lt + r16) * QST + 32 * kk + 8 * q4);
            acc = __builtin_amdgcn_mfma_f32_16x16x32_bf16(af, bfm, acc, 0, 0, 0);
          }
          const int l = 16 * lt + r16; const float M2 = s_M2[l];
          const f32x4 a2 = *(const f32x4*)(s_a2 + 16 * st + 4 * q4);
#pragma unroll
          for (int i = 0; i < 4; ++i) { const int s = 16 * st + 4 * q4 + i; acc[i] = (s <= l) ? acc[i] * __builtin_amdgcn_exp2f(a2[i] - M2) : 0.f; }
        }
        u32x2 o; o[0] = pack2(acc[0], acc[1]); o[1] = pack2(acc[2], acc[3]);
        *(u32x2*)(scm + (16 * lt + r16) * KST + 16 * st + 4 * q4) = o;
      }
    }
    f32x4 oacc[5];
#pragma unroll
    for (int i = 0; i < 5; ++i) oacc[i] = (f32x4){0.f, 0.f, 0.f, 0.f};
    {
      bf16x8 bfr[4];
#pragma unroll
      for (int kk = 0; kk < 4; ++kk) bfr[kk] = *(const bf16x8*)(CT + (16 * wid + r16) * QST + 32 * kk + 8 * q4);
#pragma unroll
      for (int lt = 0; lt < 4; ++lt)
#pragma unroll
        for (int kk = 0; kk < 4; ++kk) {
          const bf16x8 af = *(const bf16x8*)(qs + (16 * lt + r16) * QST + 32 * kk + 8 * q4);
          oacc[lt] = __builtin_amdgcn_mfma_f32_16x16x32_bf16(af, bfr[kk], oacc[lt], 0, 0, 0);
        }
      if (wid < 4) {
#pragma unroll
        for (int kk = 0; kk < 4; ++kk) {
          const bf16x8 af = *(const bf16x8*)(qs + (16 * wid + r16) * QST + 32 * kk + 8 * q4);
          const bf16x8 bd = *(const bf16x8*)(CT + (128 + r16) * QST + 32 * kk + 8 * q4);
          oacc[4] = __builtin_amdgcn_mfma_f32_16x16x32_bf16(af, bd, oacc[4], 0, 0, 0);
        }
      }
    }
    __syncthreads();
    {
#pragma unroll
      for (int lt = 0; lt < 4; ++lt) { const f32x4 g = *(const f32x4*)(s_gi + 16 * lt + 4 * q4); oacc[lt] *= g; }
      if (wid < 4) { const f32x4 g = *(const f32x4*)(s_gi + 16 * wid + 4 * q4); oacc[4] *= g; }
      bf16x8 bv[2];
#pragma unroll
      for (int kk = 0; kk < 2; ++kk) bv[kk] = *(const bf16x8*)(vT + (16 * wid + r16) * KST + 32 * kk + 8 * q4);
#pragma unroll
      for (int lt = 0; lt < 4; ++lt)
#pragma unroll
        for (int kk = 0; kk < 2; ++kk) {
          const bf16x8 af = *(const bf16x8*)(scm + (16 * lt + r16) * KST + 32 * kk + 8 * q4);
          oacc[lt] = __builtin_amdgcn_mfma_f32_16x16x32_bf16(af, bv[kk], oacc[lt], 0, 0, 0);
        }
      if (wid < 4) {
#pragma unroll
        for (int kk = 0; kk < 2; ++kk) {
          const bf16x8 af = *(const bf16x8*)(scm + (16 * wid + r16) * KST + 32 * kk + 8 * q4);
          const bf16x8 bd = *(const bf16x8*)(vT + (128 + r16) * KST + 32 * kk + 8 * q4);
          oacc[4] = __builtin_amdgcn_mfma_f32_16x16x32_bf16(af, bd, oacc[4], 0, 0, 0);
        }
      }
#pragma unroll
      for (int lt = 0; lt < 4; ++lt)
#pragma unroll
        for (int i = 0; i < 4; ++i) num[(16 * lt + 4 * q4 + i) * NST + 16 * wid + r16] = oacc[lt][i];
      if (wid < 4 && r16 == 0) {
#pragma unroll
        for (int i = 0; i < 4; ++i) s_den[16 * wid + 4 * q4 + i] = oacc[4][i];
      }
    }
    {
      const float gc = s_misc[0];
      bf16x8 ak[2];
#pragma unroll
      for (int kk = 0; kk < 2; ++kk) ak[kk] = *(const bf16x8*)(kwT + (16 * wid + r16) * KST + 32 * kk + 8 * q4);
#pragma unroll
      for (int et = 0; et < 9; ++et) {
        Cst[et] *= gc;
#pragma unroll
        for (int kk = 0; kk < 2; ++kk) {
          const bf16x8 bvv = *(const bf16x8*)(vT + (16 * et + r16) * KST + 32 * kk + 8 * q4);
          Cst[et] = __builtin_amdgcn_mfma_f32_16x16x32_bf16(ak[kk], bvv, Cst[et], 0, 0, 0);
        }
        if constexpr (MODE == 1) {
          u32x2 o; o[0] = pack2(Cst[et][0], Cst[et][1]); o[1] = pack2(Cst[et][2], Cst[et][3]);
          *(u32x2*)(CT + (16 * et + r16) * QST + 16 * wid + 4 * q4) = o;
        }
      }
    }
    __syncthreads();
    {
      const float den = s_den[erow], en = s_en[erow];
      const float inv = 1.0f / fmaxf(fabsf(den), en);
      float hv[16]; float ss = 0.f;
#pragma unroll
      for (int j = 0; j < 4; ++j) {
        const f32x4 n4 = *(const f32x4*)(num + erow * NST + 16 * epart + 4 * j);
#pragma unroll
        for (int i = 0; i < 4; ++i) { hv[4 * j + i] = n4[i] * inv; ss += hv[4 * j + i] * hv[4 * j + i]; }
      }
      ss += __shfl_xor(ss, 1); ss += __shfl_xor(ss, 2); ss += __shfl_xor(ss, 4);
      const float rs = rsqrtf(ss * (1.0f / 128.0f) + EPS);
      const float* gp = p.mlg + h * 128 + 16 * epart;
      u32x4 out[2];
#pragma unroll
      for (int j = 0; j < 8; ++j) {
        const unsigned ow = (j < 4) ? o0[j & 3] : o1[j & 3], zw = (j < 4) ? z0[j & 3] : z1[j & 3];
        const float y0 = hv[2 * j] * rs * gp[2 * j] * sigmf(bflo(ow)) * siluf(bflo(zw));
        const float y1 = hv[2 * j + 1] * rs * gp[2 * j + 1] * sigmf(bfhi(ow)) * siluf(bfhi(zw));
        out[j >> 2][j & 3] = pack2(y0, y1);
      }
      bf16_t* yp = p.y + ((size_t)b * SEQ + c * 64 + erow) * DM + 512 + h * 128 + 16 * epart;
      *(u32x4*)(yp) = out[0]; *(u32x4*)(yp + 8) = out[1];
    }
    } else {
    {
      __builtin_amdgcn_sched_barrier(0);
      const float gc = s_misc[0];
      bf16x8 ak[2];
#pragma unroll
      for (int kk = 0; kk < 2; ++kk) ak[kk] = *(const bf16x8*)(kwT + (16 * wid + r16) * KST + 32 * kk + 8 * q4);
#pragma unroll
      for (int et = 0; et < 9; ++et) {
        Cst[et] *= gc;
#pragma unroll
        for (int kk = 0; kk < 2; ++kk) {
          const bf16x8 bvv = *(const bf16x8*)(vT + (16 * et + r16) * KST + 32 * kk + 8 * q4);
          Cst[et] = __builtin_amdgcn_mfma_f32_16x16x32_bf16(ak[kk], bvv, Cst[et], 0, 0, 0);
        }
        if constexpr (MODE == 1) {
          u32x2 o; o[0] = pack2(Cst[et][0], Cst[et][1]); o[1] = pack2(Cst[et][2], Cst[et][3]);
          *(u32x2*)(CT + (16 * et + r16) * QST + 16 * wid + 4 * q4) = o;
        }
      }
    }
    }
  }
  if constexpr (MODE == 0) {
    float* lo = p.Lst + (size_t)item * (9 * 512 * 4);
#pragma unroll
    for (int et = 0; et < 9; ++et) *(f32x4*)(lo + (size_t)(et * 512 + tid) * 4) = Cst[et];
    if (tid == 0) { float gp = 1.f; for (int q = 0; q < 16; ++q) gp *= scn[q * 448 + 384]; p.gch[item] = gp; }
  }
  __syncthreads();
}


DI void ml_state_pass(const Params& p, int b, int h, int J, unsigned char* lds) {
  int tid_ = threadIdx.x; asm volatile("" : "+v"(tid_));
  const int tid = tid_, wid = tid >> 6, lane = tid & 63, r16 = lane & 15, q4 = lane >> 4;
  bf16_t* kwTb[2] = {(bf16_t*)(lds + ML_KWT), (bf16_t*)(lds + ML_SC)};
  bf16_t* vTb[2] = {(bf16_t*)(lds + ML_VT), (bf16_t*)(lds + ML_SC + 18432)};
  float* s_cw = (float*)(lds + ML_CW);
  float* scn = (float*)(lds + ML_SCN);
  const bf16_t* ub = p.u + (size_t)b * SEQ * NU;
  const float* gb = p.gates + (size_t)b * SEQ * 8;
  bf16_t* kt = p.hn + (size_t)b * SEQ * 512;
  const int c0 = J * 16, item = ((b * 4 + h) * 4 + J);
  __syncthreads();
  for (int i = tid; i < 1280; i += 512) { const int j = i >> 8, qk = (i >> 7) & 1, ch = i & 127; s_cw[i] = (j < 4) ? p.conv_w[j * 1024 + qk * 512 + h * 128 + ch] : p.conv_b[qk * 512 + h * 128 + ch]; }
  for (int i = tid; i < 16 * KST; i += 512) { const bf16_t v = (i < KST) ? (bf16_t)0x3F80 : (bf16_t)0; vTb[0][128 * KST + i] = v; vTb[1][128 * KST + i] = v; }
  f32x4 Cst[9];
#pragma unroll
  for (int e = 0; e < 9; ++e) Cst[e] = (f32x4){0.f, 0.f, 0.f, 0.f};
  {
    float* s_sum = (float*)(lds + ML_QS);
    float bcv[2], av[2], cmv[2];
    for (int cc = wid; cc < c0; cc += 8) {
      float bc = gb[(size_t)(cc * 64 + lane) * 8 + 4 + h]; const float gi = gb[(size_t)(cc * 64 + lane) * 8 + h];
#pragma unroll
      for (int o = 1; o < 64; o <<= 1) { const float t = __shfl_up(bc, o); if (lane >= o) bc += t; }
      float am = gi - bc;
#pragma unroll
      for (int o = 32; o >= 1; o >>= 1) am = fmaxf(am, __shfl_xor(am, o));
      if (lane == 63) { s_sum[2 * cc] = bc; s_sum[2 * cc + 1] = am; }
    }
#pragma unroll
    for (int q = 0; q < 2; ++q) {
      const int cc = c0 + 2 * wid + q;
      float bc = gb[(size_t)(cc * 64 + lane) * 8 + 4 + h]; const float gi = gb[(size_t)(cc * 64 + lane) * 8 + h];
#pragma unroll
      for (int o = 1; o < 64; o <<= 1) { const float t = __shfl_up(bc, o); if (lane >= o) bc += t; }
      const float a = gi - bc;
      float cm = a;
#pragma unroll
      for (int o = 1; o < 64; o <<= 1) { const float t = __shfl_up(cm, o); if (lane >= o) cm = fmaxf(cm, t); }
      bcv[q] = bc; av[q] = a; cmv[q] = cm;
      if (lane == 63) { s_sum[2 * cc] = bc; s_sum[2 * cc + 1] = cm; }
    }
    __syncthreads();
    float m_prev = 0.f;
    for (int cc = 0; cc < c0 + 2 * wid; ++cc) m_prev = s_sum[2 * cc] + fmaxf(m_prev, s_sum[2 * cc + 1]);
#pragma unroll
    for (int q = 0; q < 2; ++q) {
      float* sm = scn + (2 * wid + q) * 448;
      const float M = fmaxf(m_prev, cmv[q]);
      const float M63 = __shfl(M, 63), bl = __shfl(bcv[q], 63);
      sm[256 + lane] = __expf(av[q] - M63);
      if (lane == 0) sm[384] = __expf(m_prev - M63);
      m_prev = bl + M63;
    }
    __syncthreads();
  }
  unsigned rk[2][11], rv[2][8];
#pragma unroll
  for (int u = 0; u < 2; ++u) {
    const int base = (c0 + u) * 64 + 8 * wid;
#pragma unroll
    for (int j = 0; j < 11; ++j) { const int t = base - 3 + j; rk[u][j] = (t >= 0) ? *(const unsigned*)(ub + (size_t)t * NU + 2560 + h * 128 + 2 * lane) : 0u; }
#pragma unroll
    for (int j = 0; j < 8; ++j) rv[u][j] = *(const unsigned*)(ub + (size_t)(base + j) * NU + 3072 + h * 128 + 2 * lane);
  }
  for (int cp = 0; cp < 8; ++cp) {
    const int c = c0 + 2 * cp;
    __syncthreads();
    {
      f32x2 cwk[5];
#pragma unroll
      for (int t = 0; t < 5; ++t) cwk[t] = *(const f32x2*)(s_cw + t * 256 + 128 + 2 * lane);
#pragma unroll
      for (int u = 0; u < 2; ++u) {
        const float* s_w = scn + (2 * cp + u) * 448 + 256;
        float kq[8][2];
#pragma unroll
        for (int j = 0; j < 8; ++j) {
          float ak0 = cwk[4][0], ak1 = cwk[4][1];
#pragma unroll
          for (int t = 0; t < 4; ++t) { ak0 += cwk[t][0] * bflo(rk[u][j + t]); ak1 += cwk[t][1] * bfhi(rk[u][j + t]); }
          const unsigned pk = pack2(siluf(ak0), siluf(ak1));
          *(unsigned*)(kt + (size_t)((c + u) * 64 + 8 * wid + j) * 512 + h * 128 + 2 * lane) = pk;
          const float wj = s_w[8 * wid + j];
          kq[j][0] = bflo(pk) * wj; kq[j][1] = bfhi(pk) * wj;
        }
        u32x4 kw0, kw1, v0, v1;
#pragma unroll
        for (int j = 0; j < 4; ++j) {
          kw0[j] = pack2(kq[2 * j][0], kq[2 * j + 1][0]); kw1[j] = pack2(kq[2 * j][1], kq[2 * j + 1][1]);
          v0[j] = (rv[u][2 * j] & 0xFFFFu) | (rv[u][2 * j + 1] << 16); v1[j] = (rv[u][2 * j] >> 16) | (rv[u][2 * j + 1] & 0xFFFF0000u);
        }
        *(u32x4*)(kwTb[u] + (2 * lane) * KST + 8 * wid) = kw0; *(u32x4*)(kwTb[u] + (2 * lane + 1) * KST + 8 * wid) = kw1;
        *(u32x4*)(vTb[u] + (2 * lane) * KST + 8 * wid) = v0;   *(u32x4*)(vTb[u] + (2 * lane + 1) * KST + 8 * wid) = v1;
      }
    }
    __builtin_amdgcn_sched_barrier(0);
    if (cp < 7) {
#pragma unroll
      for (int u = 0; u < 2; ++u) {
        const int base = (c + 2 + u) * 64 + 8 * wid;
#pragma unroll
        for (int j = 0; j < 11; ++j) rk[u][j] = *(const unsigned*)(ub + (size_t)(base - 3 + j) * NU + 2560 + h * 128 + 2 * lane);
#pragma unroll
        for (int j = 0; j < 8; ++j) rv[u][j] = *(const unsigned*)(ub + (size_t)(base + j) * NU + 3072 + h * 128 + 2 * lane);
      }
    }
    __syncthreads();
#pragma unroll
    for (int u = 0; u < 2; ++u) {
      const float gc = scn[(2 * cp + u) * 448 + 384];
      bf16x8 ak[2];
#pragma unroll
      for (int kk = 0; kk < 2; ++kk) ak[kk] = *(const bf16x8*)(kwTb[u] + (16 * wid + r16) * KST + 32 * kk + 8 * q4);
#pragma unroll
      for (int et = 0; et < 9; ++et) {
        Cst[et] *= gc;
#pragma unroll
        for (int kk = 0; kk < 2; ++kk) {
          const bf16x8 bvv = *(const bf16x8*)(vTb[u] + (16 * et + r16) * KST + 32 * kk + 8 * q4);
          Cst[et] = __builtin_amdgcn_mfma_f32_16x16x32_bf16(ak[kk], bvv, Cst[et], 0, 0, 0);
        }
      }
    }
  }
  {
    float* lo = p.Lst + (size_t)item * (9 * 512 * 4);
#pragma unroll
    for (int et = 0; et < 9; ++et) *(f32x4*)(lo + (size_t)(et * 512 + tid) * 4) = Cst[et];
    if (tid == 0) { float gp = 1.f; for (int q = 0; q < 16; ++q) gp *= scn[q * 448 + 384]; p.gch[item] = gp; }
  }
  __syncthreads();
}

__global__ void __launch_bounds__(512, 2) mega(Params p) {
  extern __shared__ __attribute__((aligned(16))) unsigned char shm[];
  cg::grid_group grid = cg::this_grid();
  __shared__ uint4 xb_words;
  if (threadIdx.x == 0) xb_words = make_uint4(0u, 0u, 0u, 0u);
  __syncthreads();
  const XcdBarrier xb = xcd_barrier_post(p.bar, (volatile LAS unsigned*)&xb_words);
  if (p.bar == nullptr) grid.sync();
  phase_a(p, shm);
  xcd_barrier(xb);
  phase_b(p, shm);
  xcd_barrier(xb);
  {
    pg8::Gemm g{p.hn, p.w1t, NTOK, NU, DM};
    pg8::StaticOrder S; S.init(NTOK, NU, (int)gridDim.x, (int)blockIdx.x);
    EpiU E{p.u, p.qg, p.kg};
    pg8::gemm_phase<EpiU>((LAS unsigned char*)shm, g, S, E);
  }
  xcd_barrier(xb);
  {
    for (int it = blockIdx.x; it < 256; it += gridDim.x) ml_state_pass(p, it >> 4, (it >> 2) & 3, it & 3, shm);
    const int wid = threadIdx.x >> 6;
    bf16_t* wl = (bf16_t*)shm + wid * (32 * 72);
    for (int it = blockIdx.x; it < 1280; it += gridDim.x) { const int bh = it >> 4, q256 = it & 15; sb_wave(p, bh >> 3, bh & 7, q256 * 8 + wid, wl); }
  }
  xcd_barrier(xb);
  {
    for (int it = blockIdx.x; it < 256; it += gridDim.x) ml_super<1>(p, it >> 4, (it >> 2) & 3, it & 3, shm);
    const int wid = threadIdx.x >> 6;
    bf16_t* wl = (bf16_t*)shm + wid * (32 * 72);
    for (int it = 1280 + blockIdx.x; it < 2048; it += gridDim.x) { const int bh = it >> 4, q256 = it & 15; sb_wave(p, bh >> 3, bh & 7, q256 * 8 + wid, wl); }
  }
  xcd_barrier(xb);
  {
    pg8::Gemm g{p.y, p.w2t, NTOK, DM, DM};
    pg8::StaticOrder S; S.init(NTOK, DM, (int)gridDim.x, (int)blockIdx.x);
    EpiOut E{p.out, p.x, p.mod};
    pg8::gemm_phase<EpiOut>((LAS unsigned char*)shm, g, S, E);
  }
}

extern "C" void kernel_launch(void* const* d_in, const int* in_sizes, int n_in, void* d_out, int out_size, void* d_ws, size_t ws_size, hipStream_t stream) {
  constexpr size_t kDynLds = 163840 - 16;
  static int grid_blocks = 0;
  if (!grid_blocks) {
    int dev = 0, cus = 0, per_cu = 0;
    (void)hipGetDevice(&dev);
    (void)hipDeviceGetAttribute(&cus, hipDeviceAttributeMultiprocessorCount, dev);
    (void)hipFuncSetAttribute((const void*)mega, hipFuncAttributeMaxDynamicSharedMemorySize, (int)kDynLds);
    (void)hipOccupancyMaxActiveBlocksPerMultiprocessor(&per_cu, mega, 512, kDynLds);
    if (per_cu < 1) per_cu = 1;
    grid_blocks = cus * per_cu;
    if (grid_blocks > 256) grid_blocks = 256;
  }
  Params p{};
  p.x = (const float*)d_in[0]; p.c = (const float*)d_in[1]; p.w_ada = (const float*)d_in[2]; p.b_ada = (const float*)d_in[3];
  p.norm_gain = (const float*)d_in[4]; p.w_in = (const float*)d_in[5]; p.b_gates = (const float*)d_in[6]; p.qg = (const float*)d_in[7];
  p.kg = (const float*)d_in[8]; p.conv_w = (const float*)d_in[9]; p.conv_b = (const float*)d_in[10]; p.mlg = (const float*)d_in[11];
  p.w_out = (const float*)d_in[12];
  p.out = (float*)d_out;
  unsigned char* w = (unsigned char*)d_ws; size_t off = 0;
  auto take = [&](size_t bytes) { unsigned char* r = w + off; off += (bytes + 255) & ~(size_t)255; return r; };
  p.bar = (unsigned*)take(XCD_BAR_WORDS * 4);
  p.mod = (float*)take(16 * 3072 * 4);
  p.gates = (float*)take((size_t)NTOK * 8 * 4);
  p.gch = (float*)take(4096 * 4);
  p.Lst = (float*)take((size_t)256 * 4608 * 16);
  p.w1t = (bf16_t*)take((size_t)NU * 1024 * 2);
  p.w2t = (bf16_t*)take((size_t)1024 * 1024 * 2);
  p.hn = (bf16_t*)take((size_t)NTOK * DM * 2);
  p.u = (bf16_t*)take((size_t)NTOK * NU * 2);
  p.y = (bf16_t*)take((size_t)NTOK * DM * 2);
  (void)hipMemsetAsync(p.bar, 0, XCD_BAR_WORDS * 4, stream);
  void* args[] = {&p};
  hipError_t e = hipLaunchCooperativeKernel((void*)mega, dim3(grid_blocks), dim3(512), args, kDynLds, stream);
  if (e != hipSuccess) fprintf(stderr, "cooperative launch failed: %s (grid %d)\n", hipGetErrorString(e), grid_blocks);
}
```

```cpp
#include <hip/hip_runtime.h>
#include <hip/hip_cooperative_groups.h>
#include <cstdio>
namespace cg = cooperative_groups;

#define DI __device__ __forceinline__
#define LAS __attribute__((address_space(3)))
typedef unsigned short bf16_t;
typedef short bf16x8 __attribute__((ext_vector_type(8)));
typedef short s16x4 __attribute__((ext_vector_type(4)));
typedef float f32x4 __attribute__((ext_vector_type(4)));
typedef float f32x2 __attribute__((ext_vector_type(2)));
typedef float f32x16 __attribute__((ext_vector_type(16)));
typedef unsigned u32x4 __attribute__((ext_vector_type(4)));
typedef unsigned u32x2 __attribute__((ext_vector_type(2)));

constexpr int SEQ = 4096, NB = 16, DM = 1024, NTOK = NB * SEQ, NU = 4608, WIN_LD = 4616;
constexpr float EPS = 1e-6f, LOG2E = 1.4426950408889634f;

struct Params {
  const float* x; const float* c; const float* w_ada; const float* b_ada; const float* norm_gain; const float* w_in;
  const float* b_gates; const float* qg; const float* kg; const float* conv_w; const float* conv_b; const float* mlg; const float* w_out;
  float* out; unsigned* bar; float* mod; float* gates; float* gch; float* Lst; bf16_t* w1t; bf16_t* w2t; bf16_t* hn; bf16_t* u; bf16_t* y;
};

DI bf16_t f2bf(float f) { unsigned u = __float_as_uint(f); u += 0x7FFFu + ((u >> 16) & 1u); return (bf16_t)(u >> 16); }
DI float bf2f(bf16_t b) { return __uint_as_float(((unsigned)b) << 16); }
typedef __bf16 bf16x2_t __attribute__((ext_vector_type(2)));
DI unsigned pack2(float lo, float hi) { const f32x2 v = {lo, hi}; return __builtin_bit_cast(unsigned, __builtin_convertvector(v, bf16x2_t)); }
DI float bflo(unsigned w) { return __uint_as_float(w << 16); }
DI float bfhi(unsigned w) { return __uint_as_float(w & 0xFFFF0000u); }
DI float sigmf(float v) { return __builtin_amdgcn_rcpf(1.0f + __builtin_amdgcn_exp2f(-LOG2E * v)); }
DI float siluf(float v) { return v * sigmf(v); }
DI float wave_sum(float v) { for (int o = 32; o >= 1; o >>= 1) v += __shfl_xor(v, o); return v; }


#define XB_TMO      128
#define XB_XCNT(j)  (256  + 64 * (j))
#define XB_XSUB(j)  (1280 + 64 * (j))
#define XB_XGEN(j)  (2304 + 64 * (j))
#define XB_TOP      3328
#define XB_TOPGEN   3392
#define XCD_BAR_WORDS 3456
#define XB_SPIN_CAP (1u << 18)
DI unsigned xb_ld(unsigned* p)              { return __hip_atomic_load(p, __ATOMIC_RELAXED, __HIP_MEMORY_SCOPE_AGENT); }
DI unsigned xb_add(unsigned* p, unsigned v) { return __hip_atomic_fetch_add(p, v, __ATOMIC_RELAXED, __HIP_MEMORY_SCOPE_AGENT); }
DI unsigned xb_xcc_id() { return (unsigned)__builtin_amdgcn_s_getreg((3 << 11) | 20) & 0xFu; }
#define XB_SPIN(cond, bar) do { unsigned _sp = 0; while (cond) { __builtin_amdgcn_s_sleep(1); \
    if ((++_sp & 255u) == 0u) { if (xb_ld(&(bar)[XB_TMO])) break; if (_sp > XB_SPIN_CAP) { atomicAdd(&(bar)[XB_TMO], 1u); break; } } } } while (0)
struct XcdBarrier { unsigned* bar; unsigned x; volatile LAS unsigned* st; };
DI XcdBarrier xcd_barrier_post(unsigned* bar, volatile LAS unsigned* st) {
  XcdBarrier b; b.bar = bar; b.x = xb_xcc_id(); b.st = st;
  if (threadIdx.x == 0) (void)xb_add(&bar[XB_XCNT(b.x)], 1u);
  return b;
}
DI void xcd_barrier_complete(unsigned* bar, unsigned x, unsigned& nloc, unsigned& nx) {
  const unsigned G = gridDim.x * gridDim.y * gridDim.z;
  unsigned sum, cnt, mine, sp = 0u;
  for (;;) {
    sum = 0u; cnt = 0u; mine = 0u;
#pragma unroll
    for (unsigned j = 0; j < 16; ++j) { const unsigned c = xb_ld(&bar[XB_XCNT(j)]); sum += c; cnt += (c > 0u) ? 1u : 0u; mine = (j == x) ? c : mine; }
    if (sum == G) break;
    __builtin_amdgcn_s_sleep(1);
    if ((++sp & 255u) == 0u) { if (xb_ld(&bar[XB_TMO])) break; if (sp > XB_SPIN_CAP) { atomicAdd(&bar[XB_TMO], 1u); break; } }
  }
  nloc = mine > 0u ? mine : 1u; nx = cnt > 0u ? cnt : 1u;
}
DI void xcd_barrier(const XcdBarrier& b) {
  asm volatile("s_waitcnt vmcnt(0)" ::: "memory");
  __syncthreads();
  if (threadIdx.x == 0) {
    unsigned* bar = b.bar;
    __builtin_amdgcn_s_waitcnt(0);
    unsigned nloc = b.st[0], nx = b.st[1];
    if (nloc == 0u) { xcd_barrier_complete(bar, b.x, nloc, nx); b.st[0] = nloc; b.st[1] = nx; }
    const unsigned old = xb_add(&bar[XB_XSUB(b.x)], 1u);
    const unsigned gen = old / nloc;
    if (old + 1u == (gen + 1u) * nloc) {
      __builtin_amdgcn_fence(__ATOMIC_RELEASE, "agent");
      asm volatile("s_waitcnt vmcnt(0)" ::: "memory");
      const unsigned og = xb_add(&bar[XB_TOP], 1u);
      const unsigned tg = og / nx;
      if (og + 1u == (tg + 1u) * nx) xb_add(&bar[XB_TOPGEN], 1u);
      else XB_SPIN(xb_ld(&bar[XB_TOPGEN]) == tg, bar);
      __builtin_amdgcn_fence(__ATOMIC_ACQUIRE, "agent");
      xb_add(&bar[XB_XGEN(b.x)], 1u);
      asm volatile("s_waitcnt vmcnt(0)" ::: "memory");
    } else {
      XB_SPIN(xb_ld(&bar[XB_XGEN(b.x)]) == gen, bar);
      __builtin_amdgcn_fence(__ATOMIC_ACQUIRE, "agent");
      asm volatile("s_waitcnt vmcnt(0)" ::: "memory");
    }
  }
  __syncthreads();
}

namespace pg8 {
constexpr int BM = 256, BK = 64, HALF = 128, HTB = HALF * BK * 2, STAGE_BYTES = 8 * HTB, NXCD = 8, WGM = 8;
DI int lds_byte(int r, int c) { const int st = (r >> 4) * 2 + (c >> 5), rr = r & 15, cc = c & 31, ob = rr * 64 + cc * 2; return st * 1024 + (ob ^ (((ob >> 9) & 1) << 5)); }
DI void stage_rc(int b, int& R, int& C) { const int st = b / 1024, sb = b % 1024, swz = sb ^ (((sb >> 9) & 1) << 5); R = (st >> 1) * 16 + swz / 64; C = (st & 1) * 32 + (swz % 64) / 2; }
DI int perm32(int rho) { const int n = rho >> 4, i = rho & 15; return 8 * (i >> 2) + 4 * n + (i & 3); }
struct Unit { int pm, pn; };
struct Gemm { const bf16_t* A; const bf16_t* Bt; int M, N, K; };
struct StaticOrder {
  int nM, nN, nwg, G, c;
  DI void init(int M, int N, int G_, int c_) { nM = M / BM; nN = N / BM; nwg = nM * nN; G = G_; c = c_; }
  DI bool next(int i, Unit& u) const {
    const long L = (long)i * G + c; if (L >= nwg) return false;
    int wgid = (int)L; { const int q = nwg / NXCD, r = nwg % NXCD, xcd = wgid % NXCD, off = wgid / NXCD; wgid = (xcd < r ? xcd * (q + 1) : r * (q + 1) + (xcd - r) * q) + off; }
    const int nig = WGM * nN, gid = wgid / nig, fm = gid * WGM, gsz = (nM - fm) < WGM ? (nM - fm) : WGM;
    u.pm = fm + ((wgid % nig) % gsz); u.pn = (wgid % nig) / gsz; return true;
  }
};

template <class Epi>
DI void gemm_phase(LAS unsigned char* lds, const Gemm g, const StaticOrder& S, const Epi& E) {
  int tid_ = threadIdx.x; asm volatile("" : "+v"(tid_));
  const int tid = tid_, wid = __builtin_amdgcn_readfirstlane(tid >> 6), lane = tid & 63, wr = wid >> 2, wc = wid & 3, fr = lane & 15, fq = lane >> 4;
  const int K = g.K, nt = K / BK;
  unsigned voffA[2], voffB[2];
#pragma unroll
  for (int i = 0; i < 2; ++i) { int R, C; stage_rc(tid * 16 + i * 8192, R, C); const int Rb = Epi::PERM ? ((R & ~31) + perm32(R & 31)) : R;
    voffA[i] = (unsigned)(R * K + C) * 2u; voffB[i] = (unsigned)(Rb * K + C) * 2u; }
  const size_t kstep = (size_t)(BK * 2);
  const size_t hstep = (size_t)HALF * K * 2;
  const size_t tstep = 2 * hstep;
  const unsigned ldsw = (unsigned)wid * 1024u;
  const int aoff = lds_byte(wr * 64 + fr, fq * 8), boff = lds_byte(wc * 32 + fr, fq * 8);
#define PG8_SA(b, h) (((b) * 2 + (h)) * HTB)
#define PG8_SB(b, h) ((4 + (b) * 2 + (h)) * HTB)
#define PG8_STAGE(bufoff, gbase, voff) do { _Pragma("unroll") for (int _i = 0; _i < 2; ++_i) \
    __builtin_amdgcn_global_load_lds((const unsigned*)((const char*)(gbase) + (voff)[_i]), (LAS unsigned*)(lds + (bufoff) + ldsw + _i * 8192), 16, 0, 0); } while (0)
#define PG8_LDA(dst, b, h) do { _Pragma("unroll") for (int m = 0; m < 4; ++m) _Pragma("unroll") for (int k = 0; k < 2; ++k) dst[m][k] = *(const LAS bf16x8*)(lds + PG8_SA(b, h) + aoff + m * 2048 + k * 1024); } while (0)
#define PG8_LDB(dst, b, h) do { _Pragma("unroll") for (int n = 0; n < 2; ++n) _Pragma("unroll") for (int k = 0; k < 2; ++k) dst[n][k] = *(const LAS bf16x8*)(lds + PG8_SB(b, h) + boff + n * 2048 + k * 1024); } while (0)
#define PG8_MMA(ai, bj, At, Bt) do { __builtin_amdgcn_s_setprio(1); _Pragma("unroll") for (int m = 0; m < 4; ++m) _Pragma("unroll") for (int n = 0; n < 2; ++n) _Pragma("unroll") for (int k = 0; k < 2; ++k) \
    acc[ai][bj][m][n] = __builtin_amdgcn_mfma_f32_16x16x32_bf16(Bt[n][k], At[m][k], acc[ai][bj][m][n], 0, 0, 0); __builtin_amdgcn_s_setprio(0); } while (0)
#define PG8_WAIT_V(n) asm volatile("s_waitcnt vmcnt(" #n ")" ::: "memory")
#define PG8_WAIT_L(n) asm volatile("s_waitcnt lgkmcnt(" #n ")" ::: "memory")
#define PG8_BAR __builtin_amdgcn_s_barrier()
#define PG8_SCHED __builtin_amdgcn_sched_barrier(0)
  Unit cur, nxt; int ui = 0;
  if (!S.next(0, cur)) return;
  f32x4 acc[2][2][4][2];
#pragma unroll
  for (int a = 0; a < 2; ++a)
#pragma unroll
    for (int b = 0; b < 2; ++b)
#pragma unroll
      for (int m = 0; m < 4; ++m)
#pragma unroll
        for (int n = 0; n < 2; ++n) acc[a][b][m][n] = (f32x4){0.f, 0.f, 0.f, 0.f};
  bf16x8 At[4][2], B0[2][2], B1[2][2];
  const char* cA = (const char*)g.A + (size_t)cur.pm * tstep; const char* cB = (const char*)g.Bt + (size_t)cur.pn * tstep;
  PG8_STAGE(PG8_SB(0, 0), cB, voffB); PG8_STAGE(PG8_SA(0, 0), cA, voffA); PG8_STAGE(PG8_SB(0, 1), cB + hstep, voffB); PG8_STAGE(PG8_SA(0, 1), cA + hstep, voffA);
  if (wr == 1) PG8_BAR;
  PG8_WAIT_V(4); PG8_BAR;
  PG8_STAGE(PG8_SB(1, 0), cB + kstep, voffB); PG8_STAGE(PG8_SA(1, 0), cA + kstep, voffA); PG8_STAGE(PG8_SB(1, 1), cB + hstep + kstep, voffB);
  PG8_WAIT_V(6); PG8_BAR;
  for (;;) {
    const bool has_next = S.next(ui + 1, nxt);
    const char* nA = has_next ? (const char*)g.A + (size_t)nxt.pm * tstep : cA; const char* nB = has_next ? (const char*)g.Bt + (size_t)nxt.pn * tstep : cB;
    for (int t = 0; t < nt; t += 2) {
      const bool last = (t == nt - 2);
      const char* a1 = cA + (size_t)(t + 1) * kstep;
      const char* a2 = last ? nA : cA + (size_t)(t + 2) * kstep; const char* b2 = last ? nB : cB + (size_t)(t + 2) * kstep;
      const char* a3 = a2 + kstep; const char* b3 = b2 + kstep;
      PG8_LDB(B0, 0, 0); PG8_SCHED; PG8_LDA(At, 0, 0); PG8_STAGE(PG8_SA(1, 1), a1 + hstep, voffA);
      PG8_WAIT_L(8); PG8_BAR; PG8_WAIT_L(0); PG8_MMA(0, 0, At, B0); PG8_BAR; PG8_SCHED;
      PG8_LDB(B1, 0, 1); PG8_STAGE(PG8_SB(0, 0), b2, voffB);
      PG8_BAR; PG8_WAIT_L(0); PG8_MMA(0, 1, At, B1); PG8_BAR;
      PG8_LDA(At, 0, 1); PG8_STAGE(PG8_SA(0, 0), a2, voffA);
      PG8_BAR; PG8_WAIT_L(0); PG8_MMA(1, 0, At, B0); PG8_BAR; PG8_SCHED;
      PG8_STAGE(PG8_SB(0, 1), b2 + hstep, voffB);
      PG8_WAIT_V(6); PG8_BAR; PG8_MMA(1, 1, At, B1); PG8_BAR;
      PG8_LDB(B0, 1, 0); PG8_SCHED; PG8_LDA(At, 1, 0); PG8_STAGE(PG8_SA(0, 1), a2 + hstep, voffA);
      PG8_WAIT_L(8); PG8_BAR; PG8_WAIT_L(0); PG8_MMA(0, 0, At, B0); PG8_BAR; PG8_SCHED;
      PG8_LDB(B1, 1, 1); PG8_STAGE(PG8_SB(1, 0), b3, voffB);
      PG8_BAR; PG8_WAIT_L(0); PG8_MMA(0, 1, At, B1); PG8_BAR;
      PG8_LDA(At, 1, 1); PG8_STAGE(PG8_SA(1, 0), a3, voffA);
      PG8_BAR; PG8_WAIT_L(0); PG8_MMA(1, 0, At, B0); PG8_BAR; PG8_SCHED;
      PG8_STAGE(PG8_SB(1, 1), b3 + hstep, voffB);
      PG8_WAIT_V(6); PG8_BAR; PG8_MMA(1, 1, At, B1); PG8_BAR;
    }
    E(acc, cur, wr, wc, fr, fq);
    if (!has_next) break;
#pragma unroll
    for (int a = 0; a < 2; ++a)
#pragma unroll
      for (int b = 0; b < 2; ++b)
#pragma unroll
        for (int m = 0; m < 4; ++m)
#pragma unroll
          for (int n = 0; n < 2; ++n) acc[a][b][m][n] = (f32x4){0.f, 0.f, 0.f, 0.f};
    cur = nxt; cA = nA; cB = nB; ++ui;
  }
  PG8_WAIT_V(0);
  if (wr == 0) PG8_BAR;
  PG8_BAR;
#undef PG8_SA
#undef PG8_SB
#undef PG8_STAGE
#undef PG8_LDA
#undef PG8_LDB
#undef PG8_MMA
#undef PG8_WAIT_V
#undef PG8_WAIT_L
#undef PG8_BAR
#undef PG8_SCHED
}
}

struct EpiU {
  static constexpr bool PERM = true;
  bf16_t* U; const float* qg; const float* kg;
  DI void operator()(const f32x4 (&acc)[2][2][4][2], const pg8::Unit& u, int wr, int wc, int fr, int fq) const {
    const int row0 = u.pm * 256 + wr * 64 + fr, col0 = u.pn * 256 + wc * 64 + 8 * fq;
    if (u.pn < 4) {
      const float* gp = (u.pn < 2) ? qg : kg; const float sc = (u.pn < 2) ? (LOG2E * 0.125f) : 1.0f;
      f32x4 gv[2][2];
#pragma unroll
      for (int bj = 0; bj < 2; ++bj)
#pragma unroll
        for (int n = 0; n < 2; ++n) { gv[bj][n] = *(const f32x4*)(gp + 32 * bj + 8 * fq + 4 * n); gv[bj][n] *= sc; }
#pragma unroll
      for (int ai = 0; ai < 2; ++ai)
#pragma unroll
        for (int m = 0; m < 4; ++m) {
          bf16_t* rowp = U + (size_t)(row0 + ai * 128 + m * 16) * NU + col0;
          float ss = 0.f;
#pragma unroll
          for (int bj = 0; bj < 2; ++bj)
#pragma unroll
            for (int n = 0; n < 2; ++n)
#pragma unroll
              for (int i = 0; i < 4; ++i) ss += acc[ai][bj][m][n][i] * acc[ai][bj][m][n][i];
          ss += __shfl_xor(ss, 16); ss += __shfl_xor(ss, 32);
          const float rs = rsqrtf(ss * (1.0f / 64.0f) + EPS);
#pragma unroll
          for (int bj = 0; bj < 2; ++bj) {
            const f32x4 v0 = acc[ai][bj][m][0] * rs * gv[bj][0], v1 = acc[ai][bj][m][1] * rs * gv[bj][1];
            u32x4 o; o[0] = pack2(v0[0], v0[1]); o[1] = pack2(v0[2], v0[3]); o[2] = pack2(v1[0], v1[1]); o[3] = pack2(v1[2], v1[3]);
            *(u32x4*)(rowp + 32 * bj) = o;
          }
        }
    } else {
#pragma unroll
      for (int ai = 0; ai < 2; ++ai)
#pragma unroll
        for (int m = 0; m < 4; ++m) {
          bf16_t* rowp = U + (size_t)(row0 + ai * 128 + m * 16) * NU + col0;
#pragma unroll
          for (int bj = 0; bj < 2; ++bj) {
            const f32x4 v0 = acc[ai][bj][m][0], v1 = acc[ai][bj][m][1];
            u32x4 o; o[0] = pack2(v0[0], v0[1]); o[1] = pack2(v0[2], v0[3]); o[2] = pack2(v1[0], v1[1]); o[3] = pack2(v1[2], v1[3]);
            *(u32x4*)(rowp + 32 * bj) = o;
          }
        }
    }
  }
};

struct EpiOut {
  static constexpr bool PERM = false;
  float* O; const float* X; const float* mod;
  DI void operator()(const f32x4 (&acc)[2][2][4][2], const pg8::Unit& u, int wr, int wc, int fr, int fq) const {
    const int row0 = u.pm * 256 + wr * 64 + fr, col0 = u.pn * 256 + wc * 32 + 4 * fq;
    const int b = (u.pm * 256) >> 12;
    f32x4 gv[2][2];
#pragma unroll
    for (int bj = 0; bj < 2; ++bj)
#pragma unroll
      for (int n = 0; n < 2; ++n) gv[bj][n] = *(const f32x4*)(mod + (size_t)b * 3072 + 2048 + col0 + bj * 128 + n * 16);
#pragma unroll
    for (int ai = 0; ai < 2; ++ai) {
      f32x4 xv[4][2][2];
#pragma unroll
      for (int m = 0; m < 4; ++m)
#pragma unroll
        for (int bj = 0; bj < 2; ++bj)
#pragma unroll
          for (int n = 0; n < 2; ++n) xv[m][bj][n] = *(const f32x4*)(X + (size_t)(row0 + ai * 128 + m * 16) * DM + col0 + bj * 128 + n * 16);
      __builtin_amdgcn_sched_barrier(0);
#pragma unroll
      for (int m = 0; m < 4; ++m)
#pragma unroll
        for (int bj = 0; bj < 2; ++bj)
#pragma unroll
          for (int n = 0; n < 2; ++n) *(f32x4*)(O + (size_t)(row0 + ai * 128 + m * 16) * DM + col0 + bj * 128 + n * 16) = xv[m][bj][n] + gv[bj][n] * acc[ai][bj][m][n];
      __builtin_amdgcn_sched_barrier(0);
    }
  }
};

DI void phase_a(const Params& p, unsigned char* lds) {
  const int tid = threadIdx.x;
  float* sc = (float*)lds;
  float* red = sc + 16 * 1024;
  if (blockIdx.x < 192) {
    for (int i = tid; i < 16 * 1024; i += 512) sc[i] = siluf(p.c[i]);
    __syncthreads();
    for (int item = blockIdx.x; item < 192; item += gridDim.x) {
      const int n0 = item * 16, ks = tid >> 4, col = tid & 15;
      float acc[16];
#pragma unroll
      for (int b = 0; b < 16; ++b) acc[b] = 0.f;
      for (int kk = 0; kk < 32; ++kk) {
        const int k = kk * 32 + ks;
        const float w = p.w_ada[(size_t)k * 3072 + n0 + col];
#pragma unroll
        for (int b = 0; b < 16; ++b) acc[b] += sc[b * 1024 + k] * w;
      }
#pragma unroll
      for (int b = 0; b < 16; ++b) red[(ks * 16 + b) * 16 + col] = acc[b];
      __syncthreads();
      if (tid < 256) {
        const int b = tid >> 4; float s = 0.f;
        for (int q = 0; q < 32; ++q) s += red[(q * 16 + b) * 16 + col];
        p.mod[b * 3072 + n0 + col] = s + p.b_ada[n0 + col];
      }
      __syncthreads();
    }
  }
}
DI void weight_transposes(const Params& p, float* tile) {
  const int tid = threadIdx.x;
  for (int tt = blockIdx.x; tt < 288 + 64; tt += gridDim.x) {
    const bool first = tt < 288;
    const float* src = first ? p.w_in : p.w_out; const int ld = first ? WIN_LD : DM;
    const int t2 = first ? tt : tt - 288, ntile = first ? 72 : 16;
    const int k0 = (t2 / ntile) * 256, n0 = (t2 % ntile) * 64;
    {
      const int kk = tid >> 4, n4 = (tid & 15) * 4;
      f32x4 v[8];
#pragma unroll
      for (int i = 0; i < 8; ++i) v[i] = *(const f32x4*)(src + (size_t)(k0 + kk + 32 * i) * ld + n0 + n4);
#pragma unroll
      for (int i = 0; i < 8; ++i) *(f32x4*)(tile + (kk + 32 * i) * 68 + n4) = v[i];
    }
    __syncthreads();
    {
      const int nn = tid >> 3, k32 = (tid & 7) * 32;
      const int n = n0 + nn;
      int drow = n;
      if (first) { const int cu = n & 255; drow = (n & ~255) + 128 * ((cu >> 5) & 1) + 32 * (cu >> 6) + (cu & 31); }
      bf16_t* dst = (first ? p.w1t : p.w2t) + (size_t)drow * 1024 + k0 + k32;
#pragma unroll
      for (int q = 0; q < 4; ++q) {
        u32x4 o;
#pragma unroll
        for (int j = 0; j < 4; ++j) o[j] = pack2(tile[(k32 + 8 * q + 2 * j) * 68 + nn], tile[(k32 + 8 * q + 2 * j + 1) * 68 + nn]);
        *(u32x4*)(dst + 8 * q) = o;
      }
    }
    __syncthreads();
  }
}

DI void phase_b(const Params& p, unsigned char* lds) {
  int tid_ = threadIdx.x; asm volatile("" : "+v"(tid_));
  const int tid = tid_, wid = tid >> 6, lane = tid & 63;
  f32x4 wlo[4][4], whi[4][4];
#pragma unroll
  for (int i = 0; i < 4; ++i)
#pragma unroll
    for (int kk = 0; kk < 4; ++kk) {
      const float* wp = p.w_in + (size_t)(4 * lane + 256 * i + kk) * WIN_LD + 4608;
      wlo[i][kk] = *(const f32x4*)(wp); whi[i][kk] = *(const f32x4*)(wp + 4);
    }
  const int rpb = (NTOK + gridDim.x - 1) / gridDim.x;
  const int rbeg = blockIdx.x * rpb, rend = min(NTOK, rbeg + rpb);
  int curb = -1;
  f32x4 A[4], Bs[4];
#pragma unroll
  for (int i = 0; i < 4; ++i) { A[i] = (f32x4){0.f, 0.f, 0.f, 0.f}; Bs[i] = A[i]; }
  f32x4 xn[4];
#pragma unroll
  for (int i = 0; i < 4; ++i) xn[i] = (f32x4){0.f, 0.f, 0.f, 0.f};
  if (rbeg + wid < rend) {
#pragma unroll
    for (int i = 0; i < 4; ++i) xn[i] = *(const f32x4*)(p.x + (size_t)(rbeg + wid) * DM + 4 * lane + 256 * i);
  }
  const bool b5 = (lane & 32) != 0, b4 = (lane & 16) != 0, b3 = (lane & 8) != 0;
  const int gj = (b5 ? 4 : 0) + (b4 ? 2 : 0) + (b3 ? 1 : 0);
  const float gbias = p.b_gates[gj];
  for (int row = rbeg + wid; row < rend; row += 8) {
    const int b = row >> 12;
    if (b != curb) {
      curb = b;
#pragma unroll
      for (int i = 0; i < 4; ++i) {
        const int k = 4 * lane + 256 * i;
        const f32x4 g = *(const f32x4*)(p.norm_gain + k), s = *(const f32x4*)(p.mod + b * 3072 + 1024 + k);
        A[i] = g * (s + 1.0f); Bs[i] = *(const f32x4*)(p.mod + b * 3072 + k);
      }
    }
    f32x4 xv[4]; float ss = 0.f;
#pragma unroll
    for (int i = 0; i < 4; ++i) { xv[i] = xn[i]; ss += xv[i][0] * xv[i][0] + xv[i][1] * xv[i][1] + xv[i][2] * xv[i][2] + xv[i][3] * xv[i][3]; }
    if (row + 8 < rend) {
#pragma unroll
      for (int i = 0; i < 4; ++i) xn[i] = __builtin_nontemporal_load((const f32x4*)(p.x + (size_t)(row + 8) * DM + 4 * lane + 256 * i));
    }
    ss = wave_sum(ss);
    const float r = rsqrtf(ss * (1.0f / 1024.0f) + EPS);
    f32x4 glo = (f32x4){0.f, 0.f, 0.f, 0.f}, ghi = glo;
#pragma unroll
    for (int i = 0; i < 4; ++i) {
      const f32x4 h = xv[i] * r * A[i] + Bs[i];
      u32x2 o; o[0] = pack2(h[0], h[1]); o[1] = pack2(h[2], h[3]);
      *(u32x2*)(p.hn + (size_t)row * DM + 4 * lane + 256 * i) = o;
#pragma unroll
      for (int kk = 0; kk < 4; ++kk) { glo += wlo[i][kk] * h[kk]; ghi += whi[i][kk] * h[kk]; }
    }
    f32x4 k4, s4;
#pragma unroll
    for (int j = 0; j < 4; ++j) { k4[j] = b5 ? ghi[j] : glo[j]; s4[j] = b5 ? glo[j] : ghi[j]; }
#pragma unroll
    for (int j = 0; j < 4; ++j) k4[j] += __shfl_xor(s4[j], 32);
    float k2[2], s2[2];
#pragma unroll
    for (int j = 0; j < 2; ++j) { k2[j] = b4 ? k4[2 + j] : k4[j]; s2[j] = b4 ? k4[j] : k4[2 + j]; }
#pragma unroll
    for (int j = 0; j < 2; ++j) k2[j] += __shfl_xor(s2[j], 16);
    float v = b3 ? k2[1] : k2[0];
    const float sv = b3 ? k2[0] : k2[1];
    v += __shfl_xor(sv, 8);
    v += __shfl_xor(v, 4); v += __shfl_xor(v, 2); v += __shfl_xor(v, 1);
    if ((lane & 7) == 0) {
      v += gbias;
      if (gj >= 4) v = fminf(v, 0.f) - log1pf(__expf(-fabsf(v)));
      p.gates[(size_t)row * 8 + gj] = v;
    }
  }
  __syncthreads();
  weight_transposes(p, (float*)lds);
}

DI int crow(int reg, int h) { return (reg & 3) + 8 * (reg >> 2) + 4 * h; }
constexpr float SB_EXIT = -26.0f;

DI void sb_wave(const Params& p, int b, int h, int qt, bf16_t* wl) {
  int tid_ = threadIdx.x; asm volatile("" : "+v"(tid_));
  const int lane = tid_ & 63, r = lane & 31, hh = lane >> 5;
  const bf16_t* ub = p.u + (size_t)b * SEQ * NU;
  const int t0 = qt * 32;
  bf16x8 qf[4];
#pragma unroll
  for (int s = 0; s < 4; ++s) qf[s] = *(const bf16x8*)(ub + (size_t)(t0 + r) * NU + h * 64 + 16 * s + 8 * hh);
  bf16x8 mf[2];
#pragma unroll
  for (int s = 0; s < 2; ++s)
#pragma unroll
    for (int j = 0; j < 8; ++j) mf[s][j] = (crow(8 * s + j, hh) > r) ? (short)0x3F80 : (short)0;
  f32x16 o0, o1;
#pragma unroll
  for (int i = 0; i < 16; ++i) { o0[i] = 0.f; o1[i] = 0.f; }
  float carry = 0.f;
  const unsigned vtb = (unsigned)(size_t)wl + (unsigned)(((4 * hh + ((lane & 15) >> 2)) * 72 + 16 * ((lane >> 4) & 1) + 4 * (lane & 3)) * 2);
  const size_t trow = (size_t)b * SEQ + t0 + r;
  u32x2 zg[2][4];
  {
    const bf16_t* zp = p.u + trow * NU + 1536 + h * 64;
#pragma unroll
    for (int et = 0; et < 2; ++et)
#pragma unroll
      for (int g = 0; g < 4; ++g) zg[et][g] = *(const u32x2*)(zp + 32 * et + 8 * g + 4 * hh);
  }
  bf16x8 kn[4], vn[4];
  {
    const bf16_t* kp = ub + (size_t)(t0 + r) * NU + 512 + h * 64 + 8 * hh;
    const bf16_t* vp = ub + (size_t)(t0 + (lane >> 1)) * NU + 1024 + h * 64 + (lane & 1) * 32;
#pragma unroll
    for (int s = 0; s < 4; ++s) { kn[s] = *(const bf16x8*)(kp + 16 * s); vn[s] = *(const bf16x8*)(vp + 8 * s); }
  }
  for (int tile = qt; tile >= 0; --tile) {
    bf16x8 kf[4];
    {
      bf16x8 vv[4];
#pragma unroll
      for (int s = 0; s < 4; ++s) { kf[s] = kn[s]; vv[s] = vn[s]; }
      if (tile > 0) {
        const int s1 = (tile - 1) * 32;
        const bf16_t* kp = ub + (size_t)(s1 + r) * NU + 512 + h * 64 + 8 * hh;
        const bf16_t* vp = ub + (size_t)(s1 + (lane >> 1)) * NU + 1024 + h * 64 + (lane & 1) * 32;
#pragma unroll
        for (int s = 0; s < 4; ++s) { kn[s] = *(const bf16x8*)(kp + 16 * s); vn[s] = *(const bf16x8*)(vp + 8 * s); }
      }
      asm volatile("s_waitcnt lgkmcnt(0)" ::: "memory");
      __builtin_amdgcn_wave_barrier();
#pragma unroll
      for (int c4 = 0; c4 < 4; ++c4) *(bf16x8*)(wl + (lane >> 1) * 72 + (lane & 1) * 32 + c4 * 8) = vv[c4];
    }
    asm volatile("s_waitcnt lgkmcnt(0)" ::: "memory");
    __builtin_amdgcn_wave_barrier();
    s16x4 vt[2][2][2];
#pragma unroll
    for (int et = 0; et < 2; ++et)
#pragma unroll
      for (int s = 0; s < 2; ++s)
#pragma unroll
        for (int hf = 0; hf < 2; ++hf)
          asm volatile("ds_read_b64_tr_b16 %0, %1 offset:%2" : "=&v"(vt[et][s][hf]) : "v"(vtb), "i"((16 * s + 8 * hf) * 144 + 64 * et) : "memory");
    f32x16 S;
#pragma unroll
    for (int i = 0; i < 16; ++i) S[i] = 0.f;
#pragma unroll
    for (int s = 0; s < 4; ++s) S = __builtin_amdgcn_mfma_f32_32x32x16_bf16(kf[s], qf[s], S, 0, 0, 0);
    const bool diag = (tile == qt);
    f32x16 cin; float lm[16]; float tot = 0.f;
#pragma unroll
    for (int i = 0; i < 16; ++i) {
      const float z = S[i];
      const float e = __builtin_amdgcn_exp2f(z);
      const float sp = __builtin_amdgcn_logf(1.0f + e);
      const bool valid = !diag || (crow(i, hh) < r);
      lm[i] = valid ? -sp : 0.f;
      cin[i] = z - sp + carry;
      tot += lm[i];
    }
    tot += __shfl_xor(tot, 32);
    bf16x8 lf[2];
#pragma unroll
    for (int s = 0; s < 2; ++s) {
      u32x4 pk;
#pragma unroll
      for (int j = 0; j < 4; ++j) pk[j] = pack2(lm[8 * s + 2 * j], lm[8 * s + 2 * j + 1]);
      lf[s] = __builtin_bit_cast(bf16x8, pk);
    }
    cin = __builtin_amdgcn_mfma_f32_32x32x16_bf16(mf[0], lf[0], cin, 0, 0, 0);
    cin = __builtin_amdgcn_mfma_f32_32x32x16_bf16(mf[1], lf[1], cin, 0, 0, 0);
    bf16x8 pf[2];
#pragma unroll
    for (int s = 0; s < 2; ++s) {
      u32x4 pk;
#pragma unroll
      for (int j = 0; j < 4; ++j) {
        const int i0 = 8 * s + 2 * j, i1 = i0 + 1;
        const bool v0 = !diag || (crow(i0, hh) < r), v1 = !diag || (crow(i1, hh) < r);
        const float a0 = v0 ? __builtin_amdgcn_exp2f(cin[i0]) : 0.f, a1 = v1 ? __builtin_amdgcn_exp2f(cin[i1]) : 0.f;
        pk[j] = pack2(a0, a1);
      }
      pf[s] = __builtin_bit_cast(bf16x8, pk);
    }
    carry += tot;
    asm volatile("s_waitcnt lgkmcnt(0)" : "+v"(vt[0][0][0]), "+v"(vt[0][0][1]), "+v"(vt[0][1][0]), "+v"(vt[0][1][1]), "+v"(vt[1][0][0]), "+v"(vt[1][0][1]), "+v"(vt[1][1][0]), "+v"(vt[1][1][1]) :: "memory");
#pragma unroll
    for (int s = 0; s < 2; ++s) {
      const bf16x8 va = __builtin_shufflevector(vt[0][s][0], vt[0][s][1], 0, 1, 2, 3, 4, 5, 6, 7);
      const bf16x8 vb2 = __builtin_shufflevector(vt[1][s][0], vt[1][s][1], 0, 1, 2, 3, 4, 5, 6, 7);
      o0 = __builtin_amdgcn_mfma_f32_32x32x16_bf16(va, pf[s], o0, 0, 0, 0);
      o1 = __builtin_amdgcn_mfma_f32_32x32x16_bf16(vb2, pf[s], o1, 0, 0, 0);
    }
    if (__ballot(carry > SB_EXIT) == 0ull) break;
  }
  bf16_t* yp = p.y + trow * DM + h * 64;
#pragma unroll
  for (int et = 0; et < 2; ++et)
#pragma unroll
    for (int g = 0; g < 4; ++g) {
      const int e = 32 * et + 8 * g + 4 * hh;
      const u32x2 zz = zg[et][g];
      float v[4];
#pragma unroll
      for (int i = 0; i < 4; ++i) v[i] = (et == 0) ? o0[4 * g + i] : o1[4 * g + i];
      u32x2 ov;
      ov[0] = pack2(v[0] * siluf(bflo(zz[0])), v[1] * siluf(bfhi(zz[0])));
      ov[1] = pack2(v[2] * siluf(bflo(zz[1])), v[3] * siluf(bfhi(zz[1])));
      *(u32x2*)(yp + e) = ov;
    }
}

constexpr int ML_QS = 0, ML_KS = 17408, ML_NUM = 0, ML_KWT = 34816, ML_VT = 53248, ML_SC = 73984, ML_CT = 83200, ML_SM = 122368, ML_CW = 125568, ML_SCN = 131072;
constexpr int QST = 136, KST = 72, NST = 132;

struct MlRegs { unsigned rq[11], rk[11], rv[8]; float gi_raw, gf_raw; };

template <int MODE>
DI void ml_load_chunk(MlRegs& R, const bf16_t* ub, const bf16_t* kt, const float* gb, int c, int h, int wid, int lane, int erow, int epart) {
  const int base = c * 64 + 8 * wid;
#pragma unroll
  for (int j = 0; j < 11; ++j) {
    const int t = base - 3 + j;
    if (MODE == 1) {
      R.rq[j] = (t >= 0) ? *(const unsigned*)(ub + (size_t)t * NU + 2048 + h * 128 + 2 * lane) : 0u;
      if (j < 8) R.rk[j] = *(const unsigned*)(kt + (size_t)(base + j) * 512 + h * 128 + 2 * lane);
    } else {
      R.rk[j] = (t >= 0) ? *(const unsigned*)(ub + (size_t)t * NU + 2560 + h * 128 + 2 * lane) : 0u;
    }
  }
#pragma unroll
  for (int j = 0; j < 8; ++j) R.rv[j] = *(const unsigned*)(ub + (size_t)(base + j) * NU + 3072 + h * 128 + 2 * lane);
  if (wid == 0) { R.gi_raw = gb[(size_t)(c * 64 + lane) * 8 + h]; R.gf_raw = gb[(size_t)(c * 64 + lane) * 8 + 4 + h]; }
}

template <int MODE>
DI void ml_super(const Params& p, int b, int h, int J, unsigned char* lds) {
  int tid_ = threadIdx.x; asm volatile("" : "+v"(tid_));
  const int tid = tid_, wid = tid >> 6, lane = tid & 63, r16 = lane & 15, q4 = lane >> 4;
  bf16_t* qs = (bf16_t*)(lds + ML_QS); bf16_t* ks = (bf16_t*)(lds + ML_KS); float* num = (float*)(lds + ML_NUM);
  bf16_t* kwT = (bf16_t*)(lds + ML_KWT); bf16_t* vT = (bf16_t*)(lds + ML_VT); bf16_t* scm = (bf16_t*)(lds + ML_SC); bf16_t* CT = (bf16_t*)(lds + ML_CT);
  const bf16_t* ub = p.u + (size_t)b * SEQ * NU;
  const float* gb = p.gates + (size_t)b * SEQ * 8;
  float* s_cw = (float*)(lds + ML_CW);
  __syncthreads();
  for (int i = tid; i < 1280; i += 512) { const int j = i >> 8, qk = (i >> 7) & 1, ch = i & 127; s_cw[i] = (j < 4) ? p.conv_w[j * 1024 + qk * 512 + h * 128 + ch] : p.conv_b[qk * 512 + h * 128 + ch]; }
  for (int i = tid; i < 144 * QST / 2; i += 512) ((unsigned*)CT)[i] = 0u;
  for (int i = tid; i < 16 * KST; i += 512) vT[128 * KST + i] = (i < KST) ? (bf16_t)0x3F80 : (bf16_t)0;
  __syncthreads();
  const int c0 = J * 16, item = ((b * 4 + h) * 4 + J);
  f32x4 Cst[9];
#pragma unroll
  for (int e = 0; e < 9; ++e) Cst[e] = (f32x4){0.f, 0.f, 0.f, 0.f};
  if (MODE == 1) {
    for (int Jp = 0; Jp < J; ++Jp) {
      const float* li = p.Lst + (size_t)(item - J + Jp) * (9 * 512 * 4);
      const float G = p.gch[item - J + Jp];
#pragma unroll
      for (int et = 0; et < 9; ++et) Cst[et] = Cst[et] * G + *(const f32x4*)(li + (size_t)(et * 512 + tid) * 4);
    }
#pragma unroll
    for (int et = 0; et < 9; ++et) {
      u32x2 o; o[0] = pack2(Cst[et][0], Cst[et][1]); o[1] = pack2(Cst[et][2], Cst[et][3]);
      *(u32x2*)(CT + (16 * et + r16) * QST + 16 * wid + 4 * q4) = o;
    }
  }
  float* scn = (float*)(lds + ML_SCN);
  {
    float* s_sum = (float*)(lds + ML_KWT);
    float bcv[2], av[2], cmv[2];
    for (int cc = wid; cc < c0; cc += 8) {
      float bc = gb[(size_t)(cc * 64 + lane) * 8 + 4 + h]; const float gi = gb[(size_t)(cc * 64 + lane) * 8 + h];
#pragma unroll
      for (int o = 1; o < 64; o <<= 1) { const float t = __shfl_up(bc, o); if (lane >= o) bc += t; }
      float am = gi - bc;
#pragma unroll
      for (int o = 32; o >= 1; o >>= 1) am = fmaxf(am, __shfl_xor(am, o));
      if (lane == 63) { s_sum[2 * cc] = bc; s_sum[2 * cc + 1] = am; }
    }
#pragma unroll
    for (int q = 0; q < 2; ++q) {
      const int cc = c0 + 2 * wid + q;
      float bc = gb[(size_t)(cc * 64 + lane) * 8 + 4 + h]; const float gi = gb[(size_t)(cc * 64 + lane) * 8 + h];
#pragma unroll
      for (int o = 1; o < 64; o <<= 1) { const float t = __shfl_up(bc, o); if (lane >= o) bc += t; }
      const float a = gi - bc;
      float cm = a;
#pragma unroll
      for (int o = 1; o < 64; o <<= 1) { const float t = __shfl_up(cm, o); if (lane >= o) cm = fmaxf(cm, t); }
      bcv[q] = bc; av[q] = a; cmv[q] = cm;
      if (lane == 63) { s_sum[2 * cc] = bc; s_sum[2 * cc + 1] = cm; }
    }
    __syncthreads();
    float m_prev = 0.f;
    for (int cc = 0; cc < c0 + 2 * wid; ++cc) m_prev = s_sum[2 * cc] + fmaxf(m_prev, s_sum[2 * cc + 1]);
#pragma unroll
    for (int q = 0; q < 2; ++q) {
      float* sm = scn + (2 * wid + q) * 448;
      const float M = fmaxf(m_prev, cmv[q]);
      const float M63 = __shfl(M, 63), bl = __shfl(bcv[q], 63);
      sm[lane] = av[q] * LOG2E; sm[64 + lane] = M * LOG2E; sm[128 + lane] = __expf(m_prev - M); sm[192 + lane] = __expf(-(bcv[q] + M)); sm[256 + lane] = __expf(av[q] - M63);
      if (lane == 0) sm[384] = __expf(m_prev - M63);
      m_prev = bl + M63;
    }
    __syncthreads();
  }
  const int erow = tid >> 3, epart = tid & 7;
  MlRegs R;
  const bf16_t* kt = p.hn + (size_t)b * SEQ * 512;
  ml_load_chunk<MODE>(R, ub, kt, gb, c0, h, wid, lane, erow, epart);
  for (int c = c0; c < c0 + 16; ++c) {
    float* sm = scn + (c - c0) * 448;
    float* s_a2 = sm, *s_M2 = sm + 64, *s_gi = sm + 128, *s_en = sm + 192, *s_w = sm + 256, *s_den = sm + 320, *s_misc = sm + 384;
    __syncthreads();
    {
      float wv[8];
#pragma unroll
      for (int j = 0; j < 8; ++j) wv[j] = s_w[8 * wid + j];
      float kq[8][2];
      u32x4 kw0, kw1, v0, v1;
      f32x2 cwq[5], cwk[5];
#pragma unroll
      for (int t = 0; t < 5; ++t) { cwq[t] = *(const f32x2*)(s_cw + t * 256 + 2 * lane); cwk[t] = *(const f32x2*)(s_cw + t * 256 + 128 + 2 * lane); }
#pragma unroll
      for (int j = 0; j < 8; ++j) {
        float aq0 = cwq[4][0], aq1 = cwq[4][1], ak0 = cwk[4][0], ak1 = cwk[4][1];
#pragma unroll
        for (int t = 0; t < 4; ++t) {
          if (MODE == 1) { aq0 += cwq[t][0] * bflo(R.rq[j + t]); aq1 += cwq[t][1] * bfhi(R.rq[j + t]); }
          else { ak0 += cwk[t][0] * bflo(R.rk[j + t]); ak1 += cwk[t][1] * bfhi(R.rk[j + t]); }
        }
        float sk0, sk1;
        if (MODE == 1) { sk0 = bflo(R.rk[j]); sk1 = bfhi(R.rk[j]); }
        else {
          sk0 = siluf(ak0); sk1 = siluf(ak1);
          const unsigned pk = pack2(sk0, sk1);
          *(unsigned*)(const_cast<bf16_t*>(kt) + (size_t)(c * 64 + 8 * wid + j) * 512 + h * 128 + 2 * lane) = pk;
          sk0 = bflo(pk); sk1 = bfhi(pk);
        }
        if (MODE == 1) {
          const float sq0 = siluf(aq0) * 0.08838834764831845f, sq1 = siluf(aq1) * 0.08838834764831845f;
          *(unsigned*)(qs + (8 * wid + j) * QST + 2 * lane) = pack2(sq0, sq1);
          *(unsigned*)(ks + (8 * wid + j) * QST + 2 * lane) = pack2(sk0, sk1);
        }
        kq[j][0] = sk0 * wv[j]; kq[j][1] = sk1 * wv[j];
      }
#pragma unroll
      for (int j = 0; j < 4; ++j) {
        kw0[j] = pack2(kq[2 * j][0], kq[2 * j + 1][0]); kw1[j] = pack2(kq[2 * j][1], kq[2 * j + 1][1]);
        v0[j] = (R.rv[2 * j] & 0xFFFFu) | (R.rv[2 * j + 1] << 16); v1[j] = (R.rv[2 * j] >> 16) | (R.rv[2 * j + 1] & 0xFFFF0000u);
      }
      *(u32x4*)(kwT + (2 * lane) * KST + 8 * wid) = kw0; *(u32x4*)(kwT + (2 * lane + 1) * KST + 8 * wid) = kw1;
      *(u32x4*)(vT + (2 * lane) * KST + 8 * wid) = v0;   *(u32x4*)(vT + (2 * lane + 1) * KST + 8 * wid) = v1;
    }
    __builtin_amdgcn_sched_barrier(0);
    if (c + 1 < c0 + 16) ml_load_chunk<MODE>(R, ub, kt, gb, c + 1, h, wid, lane, erow, epart);
    __syncthreads();
    if constexpr (MODE == 1) {
    const bf16_t* op = ub + (size_t)(c * 64 + erow) * NU + 3584 + h * 128 + 16 * epart;
    const u32x4 o0 = *(const u32x4*)(op), o1 = *(const u32x4*)(op + 8), z0 = *(const u32x4*)(op + 512), z1 = *(const u32x4*)(op + 520);
    {
#pragma unroll
      for (int q = 0; q < 2; ++q) {
        const int idx = 2 * wid + q, st = idx >> 2, lt = idx & 3;
        f32x4 acc = (f32x4){0.f, 0.f, 0.f, 0.f};
        if (st <= lt) {
#pragma unroll
          for (int kk = 0; kk < 4; ++kk) {
            const bf16x8 af = *(const bf16x8*)(ks + (16 * st + r16) * QST + 32 * kk + 8 * q4);
            const bf16x8 bfm = *(const bf16x8*)(qs + (16 * lt + r16) * QST + 32 * kk + 8 * q4);
            acc = __builtin_amdgcn_mfma_f32_16x16x32_bf16(af, bfm, acc, 0, 0, 0);
          }
          const int l = 16 * lt + r16; const float M2 = s_M2[l];
          const f32x4 a2 = *(const f32x4*)(s_a2 + 16 * st + 4 * q4);
#pragma unroll
          for (int i = 0; i < 4; ++i) { const int s = 16 * st + 4 * q4 + i; acc[i] = (s <= l) ? acc[i] * __builtin_amdgcn_exp2f(a2[i] - M2) : 0.f; }
        }
        u32x2 o; o[0] = pack2(acc[0], acc[1]); o[1] = pack2(acc[2], acc[3]);
        *(u32x2*)(scm + (16 * lt + r16) * KST + 16 * st + 4 * q4) = o;
      }
    }
    f32x4 oacc[5];
#pragma unroll
    for (int i = 0; i < 5; ++i) oacc[i] = (f32x4){0.f, 0.f, 0.f, 0.f};
    {
      bf16x8 bfr[4];
#pragma unroll
      for (int kk = 0; kk < 4; ++kk) bfr[kk] = *(const bf16x8*)(CT + (16 * wid + r16) * QST + 32 * kk + 8 * q4);
#pragma unroll
      for (int lt = 0; lt < 4; ++lt)
#pragma unroll
        for (int kk = 0; kk < 4; ++kk) {
          const bf16x8 af = *(const bf16x8*)(qs + (16 * lt + r16) * QST + 32 * kk + 8 * q4);
          oacc[lt] = __builtin_amdgcn_mfma_f32_16x16x32_bf16(af, bfr[kk], oacc[lt], 0, 0, 0);
        }
      if (wid < 4) {
#pragma unroll
        for (int kk = 0; kk < 4; ++kk) {
          const bf16x8 af = *(const bf16x8*)(qs + (16 * wid + r16) * QST + 32 * kk + 8 * q4);
          const bf16x8 bd = *(const bf16x8*)(CT + (128 + r16) * QST + 32 * kk + 8 * q4);
          oacc[4] = __builtin_amdgcn_mfma_f32_16x16x32_bf16(af, bd, oacc[4], 0, 0, 0);
        }
      }
    }
    __syncthreads();
    {
#pragma unroll
      for (int lt = 0; lt < 4; ++lt) { const f32x4 g = *(const f32x4*)(s_gi + 16 * lt + 4 * q4); oacc[lt] *= g; }
      if (wid < 4) { const f32x4 g = *(const f32x4*)(s_gi + 16 * wid + 4 * q4); oacc[4] *= g; }
      bf16x8 bv[2];
#pragma unroll
      for (int kk = 0; kk < 2; ++kk) bv[kk] = *(const bf16x8*)(vT + (16 * wid + r16) * KST + 32 * kk + 8 * q4);
#pragma unroll
      for (int lt = 0; lt < 4; ++lt)
#pragma unroll
        for (int kk = 0; kk < 2; ++kk) {
          const bf16x8 af = *(const bf16x8*)(scm + (16 * lt + r16) * KST + 32 * kk + 8 * q4);
          oacc[lt] = __builtin_amdgcn_mfma_f32_16x16x32_bf16(af, bv[kk], oacc[lt], 0, 0, 0);
        }
      if (wid < 4) {
#pragma unroll
        for (int kk = 0; kk < 2; ++kk) {
          const bf16x8 af = *(const bf16x8*)(scm + (16 * wid + r16) * KST + 32 * kk + 8 * q4);
          const bf16x8 bd = *(const bf16x8*)(vT + (128 + r16) * KST + 32 * kk + 8 * q4);
          oacc[4] = __builtin_amdgcn_mfma_f32_16x16x32_bf16(af, bd, oacc[4], 0, 0, 0);
        }
      }
#pragma unroll
      for (int lt = 0; lt < 4; ++lt)
#pragma unroll
        for (int i = 0; i < 4; ++i) num[(16 * lt + 4 * q4 + i) * NST + 16 * wid + r16] = oacc[lt][i];
      if (wid < 4 && r16 == 0) {
#pragma unroll
        for (int i = 0; i < 4; ++i) s_den[16 * wid + 4 * q4 + i] = oacc[4][i];
      }
    }
    {
      const float gc = s_misc[0];
      bf16x8 ak[2];
#pragma unroll
      for (int kk = 0; kk < 2; ++kk) ak[kk] = *(const bf16x8*)(kwT + (16 * wid + r16) * KST + 32 * kk + 8 * q4);
#pragma unroll
      for (int et = 0; et < 9; ++et) {
        Cst[et] *= gc;
#pragma unroll
        for (int kk = 0; kk < 2; ++kk) {
          const bf16x8 bvv = *(const bf16x8*)(vT + (16 * et + r16) * KST + 32 * kk + 8 * q4);
          Cst[et] = __builtin_amdgcn_mfma_f32_16x16x32_bf16(ak[kk], bvv, Cst[et], 0, 0, 0);
        }
        if constexpr (MODE == 1) {
          u32x2 o; o[0] = pack2(Cst[et][0], Cst[et][1]); o[1] = pack2(Cst[et][2], Cst[et][3]);
          *(u32x2*)(CT + (16 * et + r16) * QST + 16 * wid + 4 * q4) = o;
        }
      }
    }
    __syncthreads();
    {
      const float den = s_den[erow], en = s_en[erow];
      const float inv = 1.0f / fmaxf(fabsf(den), en);
      float hv[16]; float ss = 0.f;
#pragma unroll
      for (int j = 0; j < 4; ++j) {
        const f32x4 n4 = *(const f32x4*)(num + erow * NST + 16 * epart + 4 * j);
#pragma unroll
        for (int i = 0; i < 4; ++i) { hv[4 * j + i] = n4[i] * inv; ss += hv[4 * j + i] * hv[4 * j + i]; }
      }
      ss += __shfl_xor(ss, 1); ss += __shfl_xor(ss, 2); ss += __shfl_xor(ss, 4);
      const float rs = rsqrtf(ss * (1.0f / 128.0f) + EPS);
      const float* gp = p.mlg + h * 128 + 16 * epart;
      u32x4 out[2];
#pragma unroll
      for (int j = 0; j < 8; ++j) {
        const unsigned ow = (j < 4) ? o0[j & 3] : o1[j & 3], zw = (j < 4) ? z0[j & 3] : z1[j & 3];
        const float y0 = hv[2 * j] * rs * gp[2 * j] * sigmf(bflo(ow)) * siluf(bflo(zw));
        const float y1 = hv[2 * j + 1] * rs * gp[2 * j + 1] * sigmf(bfhi(ow)) * siluf(bfhi(zw));
        out[j >> 2][j & 3] = pack2(y0, y1);
      }
      bf16_t* yp = p.y + ((size_t)b * SEQ + c * 64 + erow) * DM + 512 + h * 128 + 16 * epart;
      *(u32x4*)(yp) = out[0]; *(u32x4*)(yp + 8) = out[1];
    }
    } else {
    {
      __builtin_amdgcn_sched_barrier(0);
      const float gc = s_misc[0];
      bf16x8 ak[2];
#pragma unroll
      for (int kk = 0; kk < 2; ++kk) ak[kk] = *(const bf16x8*)(kwT + (16 * wid + r16) * KST + 32 * kk + 8 * q4);
#pragma unroll
      for (int et = 0; et < 9; ++et) {
        Cst[et] *= gc;
#pragma unroll
        for (int kk = 0; kk < 2; ++kk) {
          const bf16x8 bvv = *(const bf16x8*)(vT + (16 * et + r16) * KST + 32 * kk + 8 * q4);
          Cst[et] = __builtin_amdgcn_mfma_f32_16x16x32_bf16(ak[kk], bvv, Cst[et], 0, 0, 0);
        }
        if constexpr (MODE == 1) {
          u32x2 o; o[0] = pack2(Cst[et][0], Cst[et][1]); o[1] = pack2(Cst[et][2], Cst[et][3]);
          *(u32x2*)(CT + (16 * et + r16) * QST + 16 * wid + 4 * q4) = o;
        }
      }
    }
    }
  }
  if constexpr (MODE == 0) {
    float* lo = p.Lst + (size_t)item * (9 * 512 * 4);
#pragma unroll
    for (int et = 0; et < 9; ++et) *(f32x4*)(lo + (size_t)(et * 512 + tid) * 4) = Cst[et];
    if (tid == 0) { float gp = 1.f; for (int q = 0; q < 16; ++q) gp *= scn[q * 448 + 384]; p.gch[item] = gp; }
  }
  __syncthreads();
}


DI void ml_state_pass(const Params& p, int b, int h, int J, unsigned char* lds) {
  int tid_ = threadIdx.x; asm volatile("" : "+v"(tid_));
  const int tid = tid_, wid = tid >> 6, lane = tid & 63, r16 = lane & 15, q4 = lane >> 4;
  bf16_t* kwTb[2] = {(bf16_t*)(lds + ML_KWT), (bf16_t*)(lds + ML_SC)};
  bf16_t* vTb[2] = {(bf16_t*)(lds + ML_VT), (bf16_t*)(lds + ML_SC + 18432)};
  float* s_cw = (float*)(lds + ML_CW);
  float* scn = (float*)(lds + ML_SCN);
  const bf16_t* ub = p.u + (size_t)b * SEQ * NU;
  const float* gb = p.gates + (size_t)b * SEQ * 8;
  bf16_t* kt = p.hn + (size_t)b * SEQ * 512;
  const int c0 = J * 16, item = ((b * 4 + h) * 4 + J);
  __syncthreads();
  for (int i = tid; i < 1280; i += 512) { const int j = i >> 8, qk = (i >> 7) & 1, ch = i & 127; s_cw[i] = (j < 4) ? p.conv_w[j * 1024 + qk * 512 + h * 128 + ch] : p.conv_b[qk * 512 + h * 128 + ch]; }
  for (int i = tid; i < 16 * KST; i += 512) { const bf16_t v = (i < KST) ? (bf16_t)0x3F80 : (bf16_t)0; vTb[0][128 * KST + i] = v; vTb[1][128 * KST + i] = v; }
  f32x4 Cst[9];
#pragma unroll
  for (int e = 0; e < 9; ++e) Cst[e] = (f32x4){0.f, 0.f, 0.f, 0.f};
  {
    float* s_sum = (float*)(lds + ML_QS);
    float bcv[2], av[2], cmv[2];
    for (int cc = wid; cc < c0; cc += 8) {
      float bc = gb[(size_t)(cc * 64 + lane) * 8 + 4 + h]; const float gi = gb[(size_t)(cc * 64 + lane) * 8 + h];
#pragma unroll
      for (int o = 1; o < 64; o <<= 1) { const float t = __shfl_up(bc, o); if (lane >= o) bc += t; }
      float am = gi - bc;
#pragma unroll
      for (int o = 32; o >= 1; o >>= 1) am = fmaxf(am, __shfl_xor(am, o));
      if (lane == 63) { s_sum[2 * cc] = bc; s_sum[2 * cc + 1] = am; }
    }
#pragma unroll
    for (int q = 0; q < 2; ++q) {
      const int cc = c0 + 2 * wid + q;
      float bc = gb[(size_t)(cc * 64 + lane) * 8 + 4 + h]; const float gi = gb[(size_t)(cc * 64 + lane) * 8 + h];
#pragma unroll
      for (int o = 1; o < 64; o <<= 1) { const float t = __shfl_up(bc, o); if (lane >= o) bc += t; }
      const float a = gi - bc;
      float cm = a;
#pragma unroll
      for (int o = 1; o < 64; o <<= 1) { const float t = __shfl_up(cm, o); if (lane >= o) cm = fmaxf(cm, t); }
      bcv[q] = bc; av[q] = a; cmv[q] = cm;
      if (lane == 63) { s_sum[2 * cc] = bc; s_sum[2 * cc + 1] = cm; }
    }
    __syncthreads();
    float m_prev = 0.f;
    for (int cc = 0; cc < c0 + 2 * wid; ++cc) m_prev = s_sum[2 * cc] + fmaxf(m_prev, s_sum[2 * cc + 1]);
#pragma unroll
    for (int q = 0; q < 2; ++q) {
      float* sm = scn + (2 * wid + q) * 448;
      const float M = fmaxf(m_prev, cmv[q]);
      const float M63 = __shfl(M, 63), bl = __shfl(bcv[q], 63);
      sm[256 + lane] = __expf(av[q] - M63);
      if (lane == 0) sm[384] = __expf(m_prev - M63);
      m_prev = bl + M63;
    }
    __syncthreads();
  }
  unsigned rk[2][11], rv[2][8];
#pragma unroll
  for (int u = 0; u < 2; ++u) {
    const int base = (c0 + u) * 64 + 8 * wid;
#pragma unroll
    for (int j = 0; j < 11; ++j) { const int t = base - 3 + j; rk[u][j] = (t >= 0) ? *(const unsigned*)(ub + (size_t)t * NU + 2560 + h * 128 + 2 * lane) : 0u; }
#pragma unroll
    for (int j = 0; j < 8; ++j) rv[u][j] = *(const unsigned*)(ub + (size_t)(base + j) * NU + 3072 + h * 128 + 2 * lane);
  }
  for (int cp = 0; cp < 8; ++cp) {
    const int c = c0 + 2 * cp;
    __syncthreads();
    {
      f32x2 cwk[5];
#pragma unroll
      for (int t = 0; t < 5; ++t) cwk[t] = *(const f32x2*)(s_cw + t * 256 + 128 + 2 * lane);
#pragma unroll
      for (int u = 0; u < 2; ++u) {
        const float* s_w = scn + (2 * cp + u) * 448 + 256;
        float kq[8][2];
#pragma unroll
        for (int j = 0; j < 8; ++j) {
          float ak0 = cwk[4][0], ak1 = cwk[4][1];
#pragma unroll
          for (int t = 0; t < 4; ++t) { ak0 += cwk[t][0] * bflo(rk[u][j + t]); ak1 += cwk[t][1] * bfhi(rk[u][j + t]); }
          const unsigned pk = pack2(siluf(ak0), siluf(ak1));
          *(unsigned*)(kt + (size_t)((c + u) * 64 + 8 * wid + j) * 512 + h * 128 + 2 * lane) = pk;
          const float wj = s_w[8 * wid + j];
          kq[j][0] = bflo(pk) * wj; kq[j][1] = bfhi(pk) * wj;
        }
        u32x4 kw0, kw1, v0, v1;
#pragma unroll
        for (int j = 0; j < 4; ++j) {
          kw0[j] = pack2(kq[2 * j][0], kq[2 * j + 1][0]); kw1[j] = pack2(kq[2 * j][1], kq[2 * j + 1][1]);
          v0[j] = (rv[u][2 * j] & 0xFFFFu) | (rv[u][2 * j + 1] << 16); v1[j] = (rv[u][2 * j] >> 16) | (rv[u][2 * j + 1] & 0xFFFF0000u);
        }
        *(u32x4*)(kwTb[u] + (2 * lane) * KST + 8 * wid) = kw0; *(u32x4*)(kwTb[u] + (2 * lane + 1) * KST + 8 * wid) = kw1;
        *(u32x4*)(vTb[u] + (2 * lane) * KST + 8 * wid) = v0;   *(u32x4*)(vTb[u] + (2 * lane + 1) * KST + 8 * wid) = v1;
      }
    }
    __builtin_amdgcn_sched_barrier(0);
    if (cp < 7) {
#pragma unroll
      for (int u = 0; u < 2; ++u) {
        const int base = (c + 2 + u) * 64 + 8 * wid;
#pragma unroll
        for (int j = 0; j < 11; ++j) rk[u][j] = *(const unsigned*)(ub + (size_t)(base - 3 + j) * NU + 2560 + h * 128 + 2 * lane);
#pragma unroll
        for (int j = 0; j < 8; ++j) rv[u][j] = *(const unsigned*)(ub + (size_t)(base + j) * NU + 3072 + h * 128 + 2 * lane);
      }
    }
    __syncthreads();
#pragma unroll
    for (int u = 0; u < 2; ++u) {
      const float gc = scn[(2 * cp + u) * 448 + 384];
      bf16x8 ak[2];
#pragma unroll
      for (int kk = 0; kk < 2; ++kk) ak[kk] = *(const bf16x8*)(kwTb[u] + (16 * wid + r16) * KST + 32 * kk + 8 * q4);
#pragma unroll
      for (int et = 0; et < 9; ++et) {
        Cst[et] *= gc;
#pragma unroll
        for (int kk = 0; kk < 2; ++kk) {
          const bf16x8 bvv = *(const bf16x8*)(vTb[u] + (16 * et + r16) * KST + 32 * kk + 8 * q4);
          Cst[et] = __builtin_amdgcn_mfma_f32_16x16x32_bf16(ak[kk], bvv, Cst[et], 0, 0, 0);
        }
      }
    }
  }
  {
    float* lo = p.Lst + (size_t)item * (9 * 512 * 4);
#pragma unroll
    for (int et = 0; et < 9; ++et) *(f32x4*)(lo + (size_t)(et * 512 + tid) * 4) = Cst[et];
    if (tid == 0) { float gp = 1.f; for (int q = 0; q < 16; ++q) gp *= scn[q * 448 + 384]; p.gch[item] = gp; }
  }
  __syncthreads();
}

__global__ void __launch_bounds__(512, 2) mega(Params p) {
  extern __shared__ __attribute__((aligned(16))) unsigned char shm[];
  cg::grid_group grid = cg::this_grid();
  __shared__ uint4 xb_words;
  if (threadIdx.x == 0) xb_words = make_uint4(0u, 0u, 0u, 0u);
  __syncthreads();
  const XcdBarrier xb = xcd_barrier_post(p.bar, (volatile LAS unsigned*)&xb_words);
  if (p.bar == nullptr) grid.sync();
  phase_a(p, shm);
  xcd_barrier(xb);
  phase_b(p, shm);
  xcd_barrier(xb);
  {
    pg8::Gemm g{p.hn, p.w1t, NTOK, NU, DM};
    pg8::StaticOrder S; S.init(NTOK, NU, (int)gridDim.x, (int)blockIdx.x);
    EpiU E{p.u, p.qg, p.kg};
    pg8::gemm_phase<EpiU>((LAS unsigned char*)shm, g, S, E);
  }
  xcd_barrier(xb);
  {
    for (int it = blockIdx.x; it < 256; it += gridDim.x) ml_state_pass(p, it >> 4, (it >> 2) & 3, it & 3, shm);
    const int wid = threadIdx.x >> 6;
    bf16_t* wl = (bf16_t*)shm + wid * (32 * 72);
    for (int it = blockIdx.x; it < 1280; it += gridDim.x) { const int bh = it >> 4, q256 = it & 15; sb_wave(p, bh >> 3, bh & 7, q256 * 8 + wid, wl); }
  }
  xcd_barrier(xb);
  {
    for (int it = blockIdx.x; it < 256; it += gridDim.x) ml_super<1>(p, it >> 4, (it >> 2) & 3, it & 3, shm);
    const int wid = threadIdx.x >> 6;
    bf16_t* wl = (bf16_t*)shm + wid * (32 * 72);
    for (int it = 1280 + blockIdx.x; it < 2048; it += gridDim.x) { const int bh = it >> 4, q256 = it & 15; sb_wave(p, bh >> 3, bh & 7, q256 * 8 + wid, wl); }
  }
  xcd_barrier(xb);
  {
    pg8::Gemm g{p.y, p.w2t, NTOK, DM, DM};
    pg8::StaticOrder S; S.init(NTOK, DM, (int)gridDim.x, (int)blockIdx.x);
    EpiOut E{p.out, p.x, p.mod};
    pg8::gemm_phase<EpiOut>((LAS unsigned char*)shm, g, S, E);
  }
}

extern "C" void kernel_launch(void* const* d_in, const int* in_sizes, int n_in, void* d_out, int out_size, void* d_ws, size_t ws_size, hipStream_t stream) {
  constexpr size_t kDynLds = 163840 - 16;
  static int grid_blocks = 0;
  if (!grid_blocks) {
    int dev = 0, cus = 0, per_cu = 0;
    (void)hipGetDevice(&dev);
    (void)hipDeviceGetAttribute(&cus, hipDeviceAttributeMultiprocessorCount, dev);
    (void)hipFuncSetAttribute((const void*)mega, hipFuncAttributeMaxDynamicSharedMemorySize, (int)kDynLds);
    (void)hipOccupancyMaxActiveBlocksPerMultiprocessor(&per_cu, mega, 512, kDynLds);
    if (per_cu < 1) per_cu = 1;
    grid_blocks = cus * per_cu;
    if (grid_blocks > 256) grid_blocks = 256;
  }
  Params p{};
  p.x = (const float*)d_in[0]; p.c = (const float*)d_in[1]; p.w_ada = (const float*)d_in[2]; p.b_ada = (const float*)d_in[3];
  p.norm_gain = (const float*)d_in[4]; p.w_in = (const float*)d_in[5]; p.b_gates = (const float*)d_in[6]; p.qg = (const float*)d_in[7];
  p.kg = (const float*)d_in[8]; p.conv_w = (const float*)d_in[9]; p.conv_b = (const float*)d_in[10]; p.mlg = (const float*)d_in[11];
  p.w_out = (const float*)d_in[12];
  p.out = (float*)d_out;
  unsigned char* w = (unsigned char*)d_ws; size_t off = 0;
  auto take = [&](size_t bytes) { unsigned char* r = w + off; off += (bytes + 255) & ~(size_t)255; return r; };
  p.bar = (unsigned*)take(XCD_BAR_WORDS * 4);
  p.mod = (float*)take(16 * 3072 * 4);
  p.gates = (float*)take((size_t)NTOK * 8 * 4);
  (void)take(4096 * 4); p.gch = (float*)take(4096 * 4);
  p.Lst = (float*)take((size_t)256 * 4608 * 16); (void)take((size_t)256 * 4608 * 16);
  p.w1t = (bf16_t*)take((size_t)NU * 1024 * 2);
  p.w2t = (bf16_t*)take((size_t)1024 * 1024 * 2);
  p.hn = (bf16_t*)take((size_t)NTOK * DM * 2);
  p.u = (bf16_t*)take((size_t)NTOK * NU * 2);
  p.y = (bf16_t*)take((size_t)NTOK * DM * 2);
  (void)hipMemsetAsync(p.bar, 0, XCD_BAR_WORDS * 4, stream);
  void* args[] = {&p};
  hipError_t e = hipLaunchCooperativeKernel((void*)mega, dim3(grid_blocks), dim3(512), args, kDynLds, stream);
  if (e != hipSuccess) fprintf(stderr, "cooperative launch failed: %s (grid %d)\n", hipGetErrorString(e), grid_blocks);
}
```

```cpp
#include <hip/hip_runtime.h>
#include <hip/hip_cooperative_groups.h>
#include <cstdio>
namespace cg = cooperative_groups;

#define DI __device__ __forceinline__
#define LAS __attribute__((address_space(3)))
typedef unsigned short bf16_t;
typedef short bf16x8 __attribute__((ext_vector_type(8)));
typedef short s16x4 __attribute__((ext_vector_type(4)));
typedef float f32x4 __attribute__((ext_vector_type(4)));
typedef float f32x2 __attribute__((ext_vector_type(2)));
typedef float f32x16 __attribute__((ext_vector_type(16)));
typedef unsigned u32x4 __attribute__((ext_vector_type(4)));
typedef unsigned u32x2 __attribute__((ext_vector_type(2)));

constexpr int SEQ = 4096, NB = 16, DM = 1024, NTOK = NB * SEQ, NU = 4608, WIN_LD = 4616;
constexpr float EPS = 1e-6f, LOG2E = 1.4426950408889634f;

struct Params {
  const float* x; const float* c; const float* w_ada; const float* b_ada; const float* norm_gain; const float* w_in;
  const float* b_gates; const float* qg; const float* kg; const float* conv_w; const float* conv_b; const float* mlg; const float* w_out;
  float* out; unsigned* bar; float* mod; float* gates; float* gch; float* Lst; bf16_t* w1t; bf16_t* w2t; bf16_t* hn; bf16_t* u; bf16_t* y;
};

DI bf16_t f2bf(float f) { unsigned u = __float_as_uint(f); u += 0x7FFFu + ((u >> 16) & 1u); return (bf16_t)(u >> 16); }
DI float bf2f(bf16_t b) { return __uint_as_float(((unsigned)b) << 16); }
typedef __bf16 bf16x2_t __attribute__((ext_vector_type(2)));
DI unsigned pack2(float lo, float hi) { const f32x2 v = {lo, hi}; return __builtin_bit_cast(unsigned, __builtin_convertvector(v, bf16x2_t)); }
DI float bflo(unsigned w) { return __uint_as_float(w << 16); }
DI float bfhi(unsigned w) { return __uint_as_float(w & 0xFFFF0000u); }
DI float sigmf(float v) { return __builtin_amdgcn_rcpf(1.0f + __builtin_amdgcn_exp2f(-LOG2E * v)); }
DI float siluf(float v) { return v * sigmf(v); }
DI float wave_sum(float v) { for (int o = 32; o >= 1; o >>= 1) v += __shfl_xor(v, o); return v; }


#define XB_TMO      128
#define XB_XCNT(j)  (256  + 64 * (j))
#define XB_XSUB(j)  (1280 + 64 * (j))
#define XB_XGEN(j)  (2304 + 64 * (j))
#define XB_TOP      3328
#define XB_TOPGEN   3392
#define XCD_BAR_WORDS 3456
#define XB_SPIN_CAP (1u << 18)
DI unsigned xb_ld(unsigned* p)              { return __hip_atomic_load(p, __ATOMIC_RELAXED, __HIP_MEMORY_SCOPE_AGENT); }
DI unsigned xb_add(unsigned* p, unsigned v) { return __hip_atomic_fetch_add(p, v, __ATOMIC_RELAXED, __HIP_MEMORY_SCOPE_AGENT); }
DI unsigned xb_xcc_id() { return (unsigned)__builtin_amdgcn_s_getreg((3 << 11) | 20) & 0xFu; }
#define XB_SPIN(cond, bar) do { unsigned _sp = 0; while (cond) { __builtin_amdgcn_s_sleep(1); \
    if ((++_sp & 255u) == 0u) { if (xb_ld(&(bar)[XB_TMO])) break; if (_sp > XB_SPIN_CAP) { atomicAdd(&(bar)[XB_TMO], 1u); break; } } } } while (0)
struct XcdBarrier { unsigned* bar; unsigned x; volatile LAS unsigned* st; };
DI XcdBarrier xcd_barrier_post(unsigned* bar, volatile LAS unsigned* st) {
  XcdBarrier b; b.bar = bar; b.x = xb_xcc_id(); b.st = st;
  if (threadIdx.x == 0) (void)xb_add(&bar[XB_XCNT(b.x)], 1u);
  return b;
}
DI void xcd_barrier_complete(unsigned* bar, unsigned x, unsigned& nloc, unsigned& nx) {
  const unsigned G = gridDim.x * gridDim.y * gridDim.z;
  unsigned sum, cnt, mine, sp = 0u;
  for (;;) {
    sum = 0u; cnt = 0u; mine = 0u;
#pragma unroll
    for (unsigned j = 0; j < 16; ++j) { const unsigned c = xb_ld(&bar[XB_XCNT(j)]); sum += c; cnt += (c > 0u) ? 1u : 0u; mine = (j == x) ? c : mine; }
    if (sum == G) break;
    __builtin_amdgcn_s_sleep(1);
    if ((++sp & 255u) == 0u) { if (xb_ld(&bar[XB_TMO])) break; if (sp > XB_SPIN_CAP) { atomicAdd(&bar[XB_TMO], 1u); break; } }
  }
  nloc = mine > 0u ? mine : 1u; nx = cnt > 0u ? cnt : 1u;
}
DI void xcd_barrier(const XcdBarrier& b) {
  asm volatile("s_waitcnt vmcnt(0)" ::: "memory");
  __syncthreads();
  if (threadIdx.x == 0) {
    unsigned* bar = b.bar;
    __builtin_amdgcn_s_waitcnt(0);
    unsigned nloc = b.st[0], nx = b.st[1];
    if (nloc == 0u) { xcd_barrier_complete(bar, b.x, nloc, nx); b.st[0] = nloc; b.st[1] = nx; }
    const unsigned old = xb_add(&bar[XB_XSUB(b.x)], 1u);
    const unsigned gen = old / nloc;
    if (old + 1u == (gen + 1u) * nloc) {
      __builtin_amdgcn_fence(__ATOMIC_RELEASE, "agent");
      asm volatile("s_waitcnt vmcnt(0)" ::: "memory");
      const unsigned og = xb_add(&bar[XB_TOP], 1u);
      const unsigned tg = og / nx;
      if (og + 1u == (tg + 1u) * nx) xb_add(&bar[XB_TOPGEN], 1u);
      else XB_SPIN(xb_ld(&bar[XB_TOPGEN]) == tg, bar);
      __builtin_amdgcn_fence(__ATOMIC_ACQUIRE, "agent");
      xb_add(&bar[XB_XGEN(b.x)], 1u);
      asm volatile("s_waitcnt vmcnt(0)" ::: "memory");
    } else {
      XB_SPIN(xb_ld(&bar[XB_XGEN(b.x)]) == gen, bar);
      __builtin_amdgcn_fence(__ATOMIC_ACQUIRE, "agent");
      asm volatile("s_waitcnt vmcnt(0)" ::: "memory");
    }
  }
  __syncthreads();
}

namespace pg8 {
constexpr int BM = 256, BK = 64, HALF = 128, HTB = HALF * BK * 2, STAGE_BYTES = 8 * HTB, NXCD = 8, WGM = 8;
DI int lds_byte(int r, int c) { const int st = (r >> 4) * 2 + (c >> 5), rr = r & 15, cc = c & 31, ob = rr * 64 + cc * 2; return st * 1024 + (ob ^ (((ob >> 9) & 1) << 5)); }
DI void stage_rc(int b, int& R, int& C) { const int st = b / 1024, sb = b % 1024, swz = sb ^ (((sb >> 9) & 1) << 5); R = (st >> 1) * 16 + swz / 64; C = (st & 1) * 32 + (swz % 64) / 2; }
DI int perm32(int rho) { const int n = rho >> 4, i = rho & 15; return 8 * (i >> 2) + 4 * n + (i & 3); }
struct Unit { int pm, pn; };
struct Gemm { const bf16_t* A; const bf16_t* Bt; int M, N, K; };
struct StaticOrder {
  int nM, nN, nwg, G, c;
  DI void init(int M, int N, int G_, int c_) { nM = M / BM; nN = N / BM; nwg = nM * nN; G = G_; c = c_; }
  DI bool next(int i, Unit& u) const {
    const long L = (long)i * G + c; if (L >= nwg) return false;
    int wgid = (int)L; { const int q = nwg / NXCD, r = nwg % NXCD, xcd = wgid % NXCD, off = wgid / NXCD; wgid = (xcd < r ? xcd * (q + 1) : r * (q + 1) + (xcd - r) * q) + off; }
    const int nig = WGM * nN, gid = wgid / nig, fm = gid * WGM, gsz = (nM - fm) < WGM ? (nM - fm) : WGM;
    u.pm = fm + ((wgid % nig) % gsz); u.pn = (wgid % nig) / gsz; return true;
  }
};

template <class Epi>
DI void gemm_phase(LAS unsigned char* lds, const Gemm g, const StaticOrder& S, const Epi& E) {
  int tid_ = threadIdx.x; asm volatile("" : "+v"(tid_));
  const int tid = tid_, wid = __builtin_amdgcn_readfirstlane(tid >> 6), lane = tid & 63, wr = wid >> 2, wc = wid & 3, fr = lane & 15, fq = lane >> 4;
  const int K = g.K, nt = K / BK;
  unsigned voffA[2], voffB[2];
#pragma unroll
  for (int i = 0; i < 2; ++i) { int R, C; stage_rc(tid * 16 + i * 8192, R, C); const int Rb = Epi::PERM ? ((R & ~31) + perm32(R & 31)) : R;
    voffA[i] = (unsigned)(R * K + C) * 2u; voffB[i] = (unsigned)(Rb * K + C) * 2u; }
  const size_t kstep = (size_t)(BK * 2);
  const size_t hstep = (size_t)HALF * K * 2;
  const size_t tstep = 2 * hstep;
  const unsigned ldsw = (unsigned)wid * 1024u;
  const int aoff = lds_byte(wr * 64 + fr, fq * 8), boff = lds_byte(wc * 32 + fr, fq * 8);
#define PG8_SA(b, h) (((b) * 2 + (h)) * HTB)
#define PG8_SB(b, h) ((4 + (b) * 2 + (h)) * HTB)
#define PG8_STAGE(bufoff, gbase, voff) do { _Pragma("unroll") for (int _i = 0; _i < 2; ++_i) \
    __builtin_amdgcn_global_load_lds((const unsigned*)((const char*)(gbase) + (voff)[_i]), (LAS unsigned*)(lds + (bufoff) + ldsw + _i * 8192), 16, 0, 0); } while (0)
#define PG8_LDA(dst, b, h) do { _Pragma("unroll") for (int m = 0; m < 4; ++m) _Pragma("unroll") for (int k = 0; k < 2; ++k) dst[m][k] = *(const LAS bf16x8*)(lds + PG8_SA(b, h) + aoff + m * 2048 + k * 1024); } while (0)
#define PG8_LDB(dst, b, h) do { _Pragma("unroll") for (int n = 0; n < 2; ++n) _Pragma("unroll") for (int k = 0; k < 2; ++k) dst[n][k] = *(const LAS bf16x8*)(lds + PG8_SB(b, h) + boff + n * 2048 + k * 1024); } while (0)
#define PG8_MMA(ai, bj, At, Bt) do { __builtin_amdgcn_s_setprio(1); _Pragma("unroll") for (int m = 0; m < 4; ++m) _Pragma("unroll") for (int n = 0; n < 2; ++n) _Pragma("unroll") for (int k = 0; k < 2; ++k) \
    acc[ai][bj][m][n] = __builtin_amdgcn_mfma_f32_16x16x32_bf16(Bt[n][k], At[m][k], acc[ai][bj][m][n], 0, 0, 0); __builtin_amdgcn_s_setprio(0); } while (0)
#define PG8_WAIT_V(n) asm volatile("s_waitcnt vmcnt(" #n ")" ::: "memory")
#define PG8_WAIT_L(n) asm volatile("s_waitcnt lgkmcnt(" #n ")" ::: "memory")
#define PG8_BAR __builtin_amdgcn_s_barrier()
#define PG8_SCHED __builtin_amdgcn_sched_barrier(0)
  Unit cur, nxt; int ui = 0;
  if (!S.next(0, cur)) return;
  f32x4 acc[2][2][4][2];
#pragma unroll
  for (int a = 0; a < 2; ++a)
#pragma unroll
    for (int b = 0; b < 2; ++b)
#pragma unroll
      for (int m = 0; m < 4; ++m)
#pragma unroll
        for (int n = 0; n < 2; ++n) acc[a][b][m][n] = (f32x4){0.f, 0.f, 0.f, 0.f};
  bf16x8 At[4][2], B0[2][2], B1[2][2];
  const char* cA = (const char*)g.A + (size_t)cur.pm * tstep; const char* cB = (const char*)g.Bt + (size_t)cur.pn * tstep;
  PG8_STAGE(PG8_SB(0, 0), cB, voffB); PG8_STAGE(PG8_SA(0, 0), cA, voffA); PG8_STAGE(PG8_SB(0, 1), cB + hstep, voffB); PG8_STAGE(PG8_SA(0, 1), cA + hstep, voffA);
  if (wr == 1) PG8_BAR;
  PG8_WAIT_V(4); PG8_BAR;
  PG8_STAGE(PG8_SB(1, 0), cB + kstep, voffB); PG8_STAGE(PG8_SA(1, 0), cA + kstep, voffA); PG8_STAGE(PG8_SB(1, 1), cB + hstep + kstep, voffB);
  PG8_WAIT_V(6); PG8_BAR;
  for (;;) {
    const bool has_next = S.next(ui + 1, nxt);
    const char* nA = has_next ? (const char*)g.A + (size_t)nxt.pm * tstep : cA; const char* nB = has_next ? (const char*)g.Bt + (size_t)nxt.pn * tstep : cB;
    for (int t = 0; t < nt; t += 2) {
      const bool last = (t == nt - 2);
      const char* a1 = cA + (size_t)(t + 1) * kstep;
      const char* a2 = last ? nA : cA + (size_t)(t + 2) * kstep; const char* b2 = last ? nB : cB + (size_t)(t + 2) * kstep;
      const char* a3 = a2 + kstep; const char* b3 = b2 + kstep;
      PG8_LDB(B0, 0, 0); PG8_SCHED; PG8_LDA(At, 0, 0); PG8_STAGE(PG8_SA(1, 1), a1 + hstep, voffA);
      PG8_WAIT_L(8); PG8_BAR; PG8_WAIT_L(0); PG8_MMA(0, 0, At, B0); PG8_BAR; PG8_SCHED;
      PG8_LDB(B1, 0, 1); PG8_STAGE(PG8_SB(0, 0), b2, voffB);
      PG8_BAR; PG8_WAIT_L(0); PG8_MMA(0, 1, At, B1); PG8_BAR;
      PG8_LDA(At, 0, 1); PG8_STAGE(PG8_SA(0, 0), a2, voffA);
      PG8_BAR; PG8_WAIT_L(0); PG8_MMA(1, 0, At, B0); PG8_BAR; PG8_SCHED;
      PG8_STAGE(PG8_SB(0, 1), b2 + hstep, voffB);
      PG8_WAIT_V(6); PG8_BAR; PG8_MMA(1, 1, At, B1); PG8_BAR;
      PG8_LDB(B0, 1, 0); PG8_SCHED; PG8_LDA(At, 1, 0); PG8_STAGE(PG8_SA(0, 1), a2 + hstep, voffA);
      PG8_WAIT_L(8); PG8_BAR; PG8_WAIT_L(0); PG8_MMA(0, 0, At, B0); PG8_BAR; PG8_SCHED;
      PG8_LDB(B1, 1, 1); PG8_STAGE(PG8_SB(1, 0), b3, voffB);
      PG8_BAR; PG8_WAIT_L(0); PG8_MMA(0, 1, At, B1); PG8_BAR;
      PG8_LDA(At, 1, 1); PG8_STAGE(PG8_SA(1, 0), a3, voffA);
      PG8_BAR; PG8_WAIT_L(0); PG8_MMA(1, 0, At, B0); PG8_BAR; PG8_SCHED;
      PG8_STAGE(PG8_SB(1, 1), b3 + hstep, voffB);
      PG8_WAIT_V(6); PG8_BAR; PG8_MMA(1, 1, At, B1); PG8_BAR;
    }
    E(acc, cur, wr, wc, fr, fq);
    if (!has_next) break;
#pragma unroll
    for (int a = 0; a < 2; ++a)
#pragma unroll
      for (int b = 0; b < 2; ++b)
#pragma unroll
        for (int m = 0; m < 4; ++m)
#pragma unroll
          for (int n = 0; n < 2; ++n) acc[a][b][m][n] = (f32x4){0.f, 0.f, 0.f, 0.f};
    cur = nxt; cA = nA; cB = nB; ++ui;
  }
  PG8_WAIT_V(0);
  if (wr == 0) PG8_BAR;
  PG8_BAR;
#undef PG8_SA
#undef PG8_SB
#undef PG8_STAGE
#undef PG8_LDA
#undef PG8_LDB
#undef PG8_MMA
#undef PG8_WAIT_V
#undef PG8_WAIT_L
#undef PG8_BAR
#undef PG8_SCHED
}
}

struct EpiU {
  static constexpr bool PERM = true;
  bf16_t* U; const float* qg; const float* kg;
  DI void operator()(const f32x4 (&acc)[2][2][4][2], const pg8::Unit& u, int wr, int wc, int fr, int fq) const {
    const int row0 = u.pm * 256 + wr * 64 + fr, col0 = u.pn * 256 + wc * 64 + 8 * fq;
    if (u.pn < 4) {
      const float* gp = (u.pn < 2) ? qg : kg; const float sc = (u.pn < 2) ? (LOG2E * 0.125f) : 1.0f;
      f32x4 gv[2][2];
#pragma unroll
      for (int bj = 0; bj < 2; ++bj)
#pragma unroll
        for (int n = 0; n < 2; ++n) { gv[bj][n] = *(const f32x4*)(gp + 32 * bj + 8 * fq + 4 * n); gv[bj][n] *= sc; }
#pragma unroll
      for (int ai = 0; ai < 2; ++ai)
#pragma unroll
        for (int m = 0; m < 4; ++m) {
          bf16_t* rowp = U + (size_t)(row0 + ai * 128 + m * 16) * NU + col0;
          float ss = 0.f;
#pragma unroll
          for (int bj = 0; bj < 2; ++bj)
#pragma unroll
            for (int n = 0; n < 2; ++n)
#pragma unroll
              for (int i = 0; i < 4; ++i) ss += acc[ai][bj][m][n][i] * acc[ai][bj][m][n][i];
          ss += __shfl_xor(ss, 16); ss += __shfl_xor(ss, 32);
          const float rs = rsqrtf(ss * (1.0f / 64.0f) + EPS);
#pragma unroll
          for (int bj = 0; bj < 2; ++bj) {
            const f32x4 v0 = acc[ai][bj][m][0] * rs * gv[bj][0], v1 = acc[ai][bj][m][1] * rs * gv[bj][1];
            u32x4 o; o[0] = pack2(v0[0], v0[1]); o[1] = pack2(v0[2], v0[3]); o[2] = pack2(v1[0], v1[1]); o[3] = pack2(v1[2], v1[3]);
            *(u32x4*)(rowp + 32 * bj) = o;
          }
        }
    } else {
#pragma unroll
      for (int ai = 0; ai < 2; ++ai)
#pragma unroll
        for (int m = 0; m < 4; ++m) {
          bf16_t* rowp = U + (size_t)(row0 + ai * 128 + m * 16) * NU + col0;
#pragma unroll
          for (int bj = 0; bj < 2; ++bj) {
            const f32x4 v0 = acc[ai][bj][m][0], v1 = acc[ai][bj][m][1];
            u32x4 o; o[0] = pack2(v0[0], v0[1]); o[1] = pack2(v0[2], v0[3]); o[2] = pack2(v1[0], v1[1]); o[3] = pack2(v1[2], v1[3]);
            *(u32x4*)(rowp + 32 * bj) = o;
          }
        }
    }
  }
};

struct EpiOut {
  static constexpr bool PERM = false;
  float* O; const float* X; const float* mod;
  DI void operator()(const f32x4 (&acc)[2][2][4][2], const pg8::Unit& u, int wr, int wc, int fr, int fq) const {
    const int row0 = u.pm * 256 + wr * 64 + fr, col0 = u.pn * 256 + wc * 32 + 4 * fq;
    const int b = (u.pm * 256) >> 12;
    f32x4 gv[2][2];
#pragma unroll
    for (int bj = 0; bj < 2; ++bj)
#pragma unroll
      for (int n = 0; n < 2; ++n) gv[bj][n] = *(const f32x4*)(mod + (size_t)b * 3072 + 2048 + col0 + bj * 128 + n * 16);
#pragma unroll
    for (int ai = 0; ai < 2; ++ai) {
      f32x4 xv[4][2][2];
#pragma unroll
      for (int m = 0; m < 4; ++m)
#pragma unroll
        for (int bj = 0; bj < 2; ++bj)
#pragma unroll
          for (int n = 0; n < 2; ++n) xv[m][bj][n] = *(const f32x4*)(X + (size_t)(row0 + ai * 128 + m * 16) * DM + col0 + bj * 128 + n * 16);
      __builtin_amdgcn_sched_barrier(0);
#pragma unroll
      for (int m = 0; m < 4; ++m)
#pragma unroll
        for (int bj = 0; bj < 2; ++bj)
#pragma unroll
          for (int n = 0; n < 2; ++n) *(f32x4*)(O + (size_t)(row0 + ai * 128 + m * 16) * DM + col0 + bj * 128 + n * 16) = xv[m][bj][n] + gv[bj][n] * acc[ai][bj][m][n];
      __builtin_amdgcn_sched_barrier(0);
    }
  }
};

DI void phase_a(const Params& p, unsigned char* lds) {
  const int tid = threadIdx.x;
  float* sc = (float*)lds;
  float* red = sc + 16 * 1024;
  if (blockIdx.x < 192) {
    for (int i = tid; i < 16 * 1024; i += 512) sc[i] = siluf(p.c[i]);
    __syncthreads();
    for (int item = blockIdx.x; item < 192; item += gridDim.x) {
      const int n0 = item * 16, ks = tid >> 4, col = tid & 15;
      float acc[16];
#pragma unroll
      for (int b = 0; b < 16; ++b) acc[b] = 0.f;
      for (int kk = 0; kk < 32; ++kk) {
        const int k = kk * 32 + ks;
        const float w = p.w_ada[(size_t)k * 3072 + n0 + col];
#pragma unroll
        for (int b = 0; b < 16; ++b) acc[b] += sc[b * 1024 + k] * w;
      }
#pragma unroll
      for (int b = 0; b < 16; ++b) red[(ks * 16 + b) * 16 + col] = acc[b];
      __syncthreads();
      if (tid < 256) {
        const int b = tid >> 4; float s = 0.f;
        for (int q = 0; q < 32; ++q) s += red[(q * 16 + b) * 16 + col];
        p.mod[b * 3072 + n0 + col] = s + p.b_ada[n0 + col];
      }
      __syncthreads();
    }
  }
}
DI void weight_transposes(const Params& p, float* tile) {
  const int tid = threadIdx.x;
  for (int tt = blockIdx.x; tt < 288 + 64; tt += gridDim.x) {
    const bool first = tt < 288;
    const float* src = first ? p.w_in : p.w_out; const int ld = first ? WIN_LD : DM;
    const int t2 = first ? tt : tt - 288, ntile = first ? 72 : 16;
    const int k0 = (t2 / ntile) * 256, n0 = (t2 % ntile) * 64;
    {
      const int kk = tid >> 4, n4 = (tid & 15) * 4;
      f32x4 v[8];
#pragma unroll
      for (int i = 0; i < 8; ++i) v[i] = *(const f32x4*)(src + (size_t)(k0 + kk + 32 * i) * ld + n0 + n4);
#pragma unroll
      for (int i = 0; i < 8; ++i) *(f32x4*)(tile + (kk + 32 * i) * 68 + n4) = v[i];
    }
    __syncthreads();
    {
      const int nn = tid >> 3, k32 = (tid & 7) * 32;
      const int n = n0 + nn;
      int drow = n;
      if (first) { const int cu = n & 255; drow = (n & ~255) + 128 * ((cu >> 5) & 1) + 32 * (cu >> 6) + (cu & 31); }
      bf16_t* dst = (first ? p.w1t : p.w2t) + (size_t)drow * 1024 + k0 + k32;
#pragma unroll
      for (int q = 0; q < 4; ++q) {
        u32x4 o;
#pragma unroll
        for (int j = 0; j < 4; ++j) o[j] = pack2(tile[(k32 + 8 * q + 2 * j) * 68 + nn], tile[(k32 + 8 * q + 2 * j + 1) * 68 + nn]);
        *(u32x4*)(dst + 8 * q) = o;
      }
    }
    __syncthreads();
  }
}

DI void phase_b(const Params& p, unsigned char* lds) {
  int tid_ = threadIdx.x; asm volatile("" : "+v"(tid_));
  const int tid = tid_, wid = tid >> 6, lane = tid & 63;
  f32x4 wlo[4][4], whi[4][4];
#pragma unroll
  for (int i = 0; i < 4; ++i)
#pragma unroll
    for (int kk = 0; kk < 4; ++kk) {
      const float* wp = p.w_in + (size_t)(4 * lane + 256 * i + kk) * WIN_LD + 4608;
      wlo[i][kk] = *(const f32x4*)(wp); whi[i][kk] = *(const f32x4*)(wp + 4);
    }
  const int rpb = (NTOK + gridDim.x - 1) / gridDim.x;
  const int rbeg = blockIdx.x * rpb, rend = min(NTOK, rbeg + rpb);
  int curb = -1;
  f32x4 A[4], Bs[4];
#pragma unroll
  for (int i = 0; i < 4; ++i) { A[i] = (f32x4){0.f, 0.f, 0.f, 0.f}; Bs[i] = A[i]; }
  f32x4 xn[4];
#pragma unroll
  for (int i = 0; i < 4; ++i) xn[i] = (f32x4){0.f, 0.f, 0.f, 0.f};
  if (rbeg + wid < rend) {
#pragma unroll
    for (int i = 0; i < 4; ++i) xn[i] = *(const f32x4*)(p.x + (size_t)(rbeg + wid) * DM + 4 * lane + 256 * i);
  }
  const bool b5 = (lane & 32) != 0, b4 = (lane & 16) != 0, b3 = (lane & 8) != 0;
  const int gj = (b5 ? 4 : 0) + (b4 ? 2 : 0) + (b3 ? 1 : 0);
  const float gbias = p.b_gates[gj];
  for (int row = rbeg + wid; row < rend; row += 8) {
    const int b = row >> 12;
    if (b != curb) {
      curb = b;
#pragma unroll
      for (int i = 0; i < 4; ++i) {
        const int k = 4 * lane + 256 * i;
        const f32x4 g = *(const f32x4*)(p.norm_gain + k), s = *(const f32x4*)(p.mod + b * 3072 + 1024 + k);
        A[i] = g * (s + 1.0f); Bs[i] = *(const f32x4*)(p.mod + b * 3072 + k);
      }
    }
    f32x4 xv[4]; float ss = 0.f;
#pragma unroll
    for (int i = 0; i < 4; ++i) { xv[i] = xn[i]; ss += xv[i][0] * xv[i][0] + xv[i][1] * xv[i][1] + xv[i][2] * xv[i][2] + xv[i][3] * xv[i][3]; }
    if (row + 8 < rend) {
#pragma unroll
      for (int i = 0; i < 4; ++i) xn[i] = __builtin_nontemporal_load((const f32x4*)(p.x + (size_t)(row + 8) * DM + 4 * lane + 256 * i));
    }
    ss = wave_sum(ss);
    const float r = rsqrtf(ss * (1.0f / 1024.0f) + EPS);
    f32x4 glo = (f32x4){0.f, 0.f, 0.f, 0.f}, ghi = glo;
#pragma unroll
    for (int i = 0; i < 4; ++i) {
      const f32x4 h = xv[i] * r * A[i] + Bs[i];
      u32x2 o; o[0] = pack2(h[0], h[1]); o[1] = pack2(h[2], h[3]);
      *(u32x2*)(p.hn + (size_t)row * DM + 4 * lane + 256 * i) = o;
#pragma unroll
      for (int kk = 0; kk < 4; ++kk) { glo += wlo[i][kk] * h[kk]; ghi += whi[i][kk] * h[kk]; }
    }
    f32x4 k4, s4;
#pragma unroll
    for (int j = 0; j < 4; ++j) { k4[j] = b5 ? ghi[j] : glo[j]; s4[j] = b5 ? glo[j] : ghi[j]; }
#pragma unroll
    for (int j = 0; j < 4; ++j) k4[j] += __shfl_xor(s4[j], 32);
    float k2[2], s2[2];
#pragma unroll
    for (int j = 0; j < 2; ++j) { k2[j] = b4 ? k4[2 + j] : k4[j]; s2[j] = b4 ? k4[j] : k4[2 + j]; }
#pragma unroll
    for (int j = 0; j < 2; ++j) k2[j] += __shfl_xor(s2[j], 16);
    float v = b3 ? k2[1] : k2[0];
    const float sv = b3 ? k2[0] : k2[1];
    v += __shfl_xor(sv, 8);
    v += __shfl_xor(v, 4); v += __shfl_xor(v, 2); v += __shfl_xor(v, 1);
    if ((lane & 7) == 0) {
      v += gbias;
      if (gj >= 4) v = fminf(v, 0.f) - log1pf(__expf(-fabsf(v)));
      p.gates[(size_t)row * 8 + gj] = v;
    }
  }
  __syncthreads();
  weight_transposes(p, (float*)lds);
}

DI int crow(int reg, int h) { return (reg & 3) + 8 * (reg >> 2) + 4 * h; }
constexpr float SB_EXIT = -26.0f;

DI void sb_wave(const Params& p, int b, int h, int qt, bf16_t* wl) {
  int tid_ = threadIdx.x; asm volatile("" : "+v"(tid_));
  const int lane = tid_ & 63, r = lane & 31, hh = lane >> 5;
  const bf16_t* ub = p.u + (size_t)b * SEQ * NU;
  const int t0 = qt * 32;
  bf16_t* kl = wl + 8 * (32 * 72);
  const int crw = lane >> 3, cch = (lane & 7) * 8;
  bf16x8 qf[4], zc[4];
  {
    const bf16_t* qp = ub + (size_t)(t0 + crw) * NU + h * 64 + cch;
#pragma unroll
    for (int s = 0; s < 4; ++s) { qf[s] = *(const bf16x8*)(qp + (size_t)(8 * s) * NU); zc[s] = *(const bf16x8*)(qp + (size_t)(8 * s) * NU + 1536); }
    asm volatile("s_waitcnt lgkmcnt(0)" ::: "memory");
    __builtin_amdgcn_wave_barrier();
#pragma unroll
    for (int s = 0; s < 4; ++s) *(bf16x8*)(kl + (crw + 8 * s) * 72 + cch) = qf[s];
    asm volatile("s_waitcnt lgkmcnt(0)" ::: "memory");
    __builtin_amdgcn_wave_barrier();
#pragma unroll
    for (int s = 0; s < 4; ++s) qf[s] = *(const bf16x8*)(kl + r * 72 + 16 * s + 8 * hh);
    asm volatile("s_waitcnt lgkmcnt(0)" ::: "memory");
    __builtin_amdgcn_wave_barrier();
  }
  bf16x8 mf[2];
#pragma unroll
  for (int s = 0; s < 2; ++s)
#pragma unroll
    for (int j = 0; j < 8; ++j) mf[s][j] = (crow(8 * s + j, hh) > r) ? (short)0x3F80 : (short)0;
  f32x16 o0, o1;
#pragma unroll
  for (int i = 0; i < 16; ++i) { o0[i] = 0.f; o1[i] = 0.f; }
  float carry = 0.f;
  const unsigned vtb = (unsigned)(size_t)wl + (unsigned)(((4 * hh + ((lane & 15) >> 2)) * 72 + 16 * ((lane >> 4) & 1) + 4 * (lane & 3)) * 2);
  bf16x8 kn[4], vn[4];
  {
    const bf16_t* kp = ub + (size_t)(t0 + crw) * NU + 512 + h * 64 + cch;
#pragma unroll
    for (int s = 0; s < 4; ++s) { kn[s] = *(const bf16x8*)(kp + (size_t)(8 * s) * NU); vn[s] = *(const bf16x8*)(kp + (size_t)(8 * s) * NU + 512); }
  }
  for (int tile = qt; tile >= 0; --tile) {
    bf16x8 kf[4];
    {
      bf16x8 vv[4];
#pragma unroll
      for (int s = 0; s < 4; ++s) { kf[s] = kn[s]; vv[s] = vn[s]; }
      if (tile > 0) {
        const int s1 = (tile - 1) * 32;
        const bf16_t* kp = ub + (size_t)(s1 + crw) * NU + 512 + h * 64 + cch;
#pragma unroll
        for (int s = 0; s < 4; ++s) { kn[s] = *(const bf16x8*)(kp + (size_t)(8 * s) * NU); vn[s] = *(const bf16x8*)(kp + (size_t)(8 * s) * NU + 512); }
      }
      asm volatile("s_waitcnt lgkmcnt(0)" ::: "memory");
      __builtin_amdgcn_wave_barrier();
#pragma unroll
      for (int c4 = 0; c4 < 4; ++c4) { *(bf16x8*)(wl + (crw + 8 * c4) * 72 + cch) = vv[c4]; *(bf16x8*)(kl + (crw + 8 * c4) * 72 + cch) = kf[c4]; }
    }
    asm volatile("s_waitcnt lgkmcnt(0)" ::: "memory");
    __builtin_amdgcn_wave_barrier();
#pragma unroll
    for (int s = 0; s < 4; ++s) kf[s] = *(const bf16x8*)(kl + r * 72 + 16 * s + 8 * hh);
    s16x4 vt[2][2][2];
#pragma unroll
    for (int et = 0; et < 2; ++et)
#pragma unroll
      for (int s = 0; s < 2; ++s)
#pragma unroll
        for (int hf = 0; hf < 2; ++hf)
          asm volatile("ds_read_b64_tr_b16 %0, %1 offset:%2" : "=&v"(vt[et][s][hf]) : "v"(vtb), "i"((16 * s + 8 * hf) * 144 + 64 * et) : "memory");
    f32x16 S;
#pragma unroll
    for (int i = 0; i < 16; ++i) S[i] = 0.f;
#pragma unroll
    for (int s = 0; s < 4; ++s) S = __builtin_amdgcn_mfma_f32_32x32x16_bf16(kf[s], qf[s], S, 0, 0, 0);
    const bool diag = (tile == qt);
    f32x16 cin; float lm[16]; float tot = 0.f;
#pragma unroll
    for (int i = 0; i < 16; ++i) {
      const float z = S[i];
      const float e = __builtin_amdgcn_exp2f(z);
      const float sp = __builtin_amdgcn_logf(1.0f + e);
      const bool valid = !diag || (crow(i, hh) < r);
      lm[i] = valid ? -sp : 0.f;
      cin[i] = z - sp + carry;
      tot += lm[i];
    }
    tot += __shfl_xor(tot, 32);
    bf16x8 lf[2];
#pragma unroll
    for (int s = 0; s < 2; ++s) {
      u32x4 pk;
#pragma unroll
      for (int j = 0; j < 4; ++j) pk[j] = pack2(lm[8 * s + 2 * j], lm[8 * s + 2 * j + 1]);
      lf[s] = __builtin_bit_cast(bf16x8, pk);
    }
    cin = __builtin_amdgcn_mfma_f32_32x32x16_bf16(mf[0], lf[0], cin, 0, 0, 0);
    cin = __builtin_amdgcn_mfma_f32_32x32x16_bf16(mf[1], lf[1], cin, 0, 0, 0);
    bf16x8 pf[2];
#pragma unroll
    for (int s = 0; s < 2; ++s) {
      u32x4 pk;
#pragma unroll
      for (int j = 0; j < 4; ++j) {
        const int i0 = 8 * s + 2 * j, i1 = i0 + 1;
        const bool v0 = !diag || (crow(i0, hh) < r), v1 = !diag || (crow(i1, hh) < r);
        const float a0 = v0 ? __builtin_amdgcn_exp2f(cin[i0]) : 0.f, a1 = v1 ? __builtin_amdgcn_exp2f(cin[i1]) : 0.f;
        pk[j] = pack2(a0, a1);
      }
      pf[s] = __builtin_bit_cast(bf16x8, pk);
    }
    carry += tot;
    asm volatile("s_waitcnt lgkmcnt(0)" : "+v"(vt[0][0][0]), "+v"(vt[0][0][1]), "+v"(vt[0][1][0]), "+v"(vt[0][1][1]), "+v"(vt[1][0][0]), "+v"(vt[1][0][1]), "+v"(vt[1][1][0]), "+v"(vt[1][1][1]) :: "memory");
#pragma unroll
    for (int s = 0; s < 2; ++s) {
      const bf16x8 va = __builtin_shufflevector(vt[0][s][0], vt[0][s][1], 0, 1, 2, 3, 4, 5, 6, 7);
      const bf16x8 vb2 = __builtin_shufflevector(vt[1][s][0], vt[1][s][1], 0, 1, 2, 3, 4, 5, 6, 7);
      o0 = __builtin_amdgcn_mfma_f32_32x32x16_bf16(va, pf[s], o0, 0, 0, 0);
      o1 = __builtin_amdgcn_mfma_f32_32x32x16_bf16(vb2, pf[s], o1, 0, 0, 0);
    }
    if (__ballot(carry > SB_EXIT) == 0ull) break;
  }
  asm volatile("s_waitcnt lgkmcnt(0)" ::: "memory");
  __builtin_amdgcn_wave_barrier();
#pragma unroll
  for (int s = 0; s < 4; ++s) *(bf16x8*)(kl + (crw + 8 * s) * 72 + cch) = zc[s];
  asm volatile("s_waitcnt lgkmcnt(0)" ::: "memory");
  __builtin_amdgcn_wave_barrier();
#pragma unroll
  for (int et = 0; et < 2; ++et)
#pragma unroll
    for (int g = 0; g < 4; ++g) {
      const int e = 32 * et + 8 * g + 4 * hh;
      const u32x2 zz = *(const u32x2*)(kl + r * 72 + e);
      float v[4];
#pragma unroll
      for (int i = 0; i < 4; ++i) v[i] = (et == 0) ? o0[4 * g + i] : o1[4 * g + i];
      u32x2 ov;
      ov[0] = pack2(v[0] * siluf(bflo(zz[0])), v[1] * siluf(bfhi(zz[0])));
      ov[1] = pack2(v[2] * siluf(bflo(zz[1])), v[3] * siluf(bfhi(zz[1])));
      *(u32x2*)(wl + r * 72 + e) = ov;
    }
  asm volatile("s_waitcnt lgkmcnt(0)" ::: "memory");
  __builtin_amdgcn_wave_barrier();
  {
    bf16_t* yp = p.y + ((size_t)b * SEQ + t0 + crw) * DM + h * 64 + cch;
#pragma unroll
    for (int s = 0; s < 4; ++s) *(bf16x8*)(yp + (size_t)(8 * s) * DM) = *(const bf16x8*)(wl + (crw + 8 * s) * 72 + cch);
  }
  asm volatile("s_waitcnt lgkmcnt(0)" ::: "memory");
  __builtin_amdgcn_wave_barrier();
}

constexpr int ML_QS = 0, ML_KS = 17408, ML_NUM = 0, ML_KWT = 34816, ML_VT = 53248, ML_SC = 73984, ML_CT = 83200, ML_SM = 122368, ML_CW = 125568, ML_SCN = 131072;
constexpr int QST = 136, KST = 72, NST = 132;

struct MlRegs { unsigned rq[11], rk[11], rv[8]; float gi_raw, gf_raw; };

template <int MODE>
DI void ml_load_chunk(MlRegs& R, const bf16_t* ub, const bf16_t* kt, const float* gb, int c, int h, int wid, int lane, int erow, int epart) {
  const int base = c * 64 + 8 * wid;
#pragma unroll
  for (int j = 0; j < 11; ++j) {
    const int t = base - 3 + j;
    if (MODE == 1) {
      R.rq[j] = (t >= 0) ? *(const unsigned*)(ub + (size_t)t * NU + 2048 + h * 128 + 2 * lane) : 0u;
      if (j < 8) R.rk[j] = *(const unsigned*)(kt + (size_t)(base + j) * 512 + h * 128 + 2 * lane);
    } else {
      R.rk[j] = (t >= 0) ? *(const unsigned*)(ub + (size_t)t * NU + 2560 + h * 128 + 2 * lane) : 0u;
    }
  }
#pragma unroll
  for (int j = 0; j < 8; ++j) R.rv[j] = *(const unsigned*)(ub + (size_t)(base + j) * NU + 3072 + h * 128 + 2 * lane);
  if (wid == 0) { R.gi_raw = gb[(size_t)(c * 64 + lane) * 8 + h]; R.gf_raw = gb[(size_t)(c * 64 + lane) * 8 + 4 + h]; }
}

template <int MODE>
DI void ml_super(const Params& p, int b, int h, int J, unsigned char* lds) {
  int tid_ = threadIdx.x; asm volatile("" : "+v"(tid_));
  const int tid = tid_, wid = tid >> 6, lane = tid & 63, r16 = lane & 15, q4 = lane >> 4;
  bf16_t* qs = (bf16_t*)(lds + ML_QS); bf16_t* ks = (bf16_t*)(lds + ML_KS); float* num = (float*)(lds + ML_NUM);
  bf16_t* kwT = (bf16_t*)(lds + ML_KWT); bf16_t* vT = (bf16_t*)(lds + ML_VT); bf16_t* scm = (bf16_t*)(lds + ML_SC); bf16_t* CT = (bf16_t*)(lds + ML_CT);
  const bf16_t* ub = p.u + (size_t)b * SEQ * NU;
  const float* gb = p.gates + (size_t)b * SEQ * 8;
  float* s_cw = (float*)(lds + ML_CW);
  __syncthreads();
  for (int i = tid; i < 1280; i += 512) { const int j = i >> 8, qk = (i >> 7) & 1, ch = i & 127; s_cw[i] = (j < 4) ? p.conv_w[j * 1024 + qk * 512 + h * 128 + ch] : p.conv_b[qk * 512 + h * 128 + ch]; }
  for (int i = tid; i < 144 * QST / 2; i += 512) ((unsigned*)CT)[i] = 0u;
  for (int i = tid; i < 16 * KST; i += 512) vT[128 * KST + i] = (i < KST) ? (bf16_t)0x3F80 : (bf16_t)0;
  __syncthreads();
  const int c0 = J * 16, item = ((b * 4 + h) * 4 + J);
  f32x4 Cst[9];
#pragma unroll
  for (int e = 0; e < 9; ++e) Cst[e] = (f32x4){0.f, 0.f, 0.f, 0.f};
  if (MODE == 1) {
    for (int Jp = 0; Jp < J; ++Jp) {
      const float* li = p.Lst + (size_t)(item - J + Jp) * (9 * 512 * 4);
      const float G = p.gch[item - J + Jp];
#pragma unroll
      for (int et = 0; et < 9; ++et) Cst[et] = Cst[et] * G + *(const f32x4*)(li + (size_t)(et * 512 + tid) * 4);
    }
#pragma unroll
    for (int et = 0; et < 9; ++et) {
      u32x2 o; o[0] = pack2(Cst[et][0], Cst[et][1]); o[1] = pack2(Cst[et][2], Cst[et][3]);
      *(u32x2*)(CT + (16 * et + r16) * QST + 16 * wid + 4 * q4) = o;
    }
  }
  float* scn = (float*)(lds + ML_SCN);
  {
    float* s_sum = (float*)(lds + ML_KWT);
    float bcv[2], av[2], cmv[2];
    for (int cc = wid; cc < c0; cc += 8) {
      float bc = gb[(size_t)(cc * 64 + lane) * 8 + 4 + h]; const float gi = gb[(size_t)(cc * 64 + lane) * 8 + h];
#pragma unroll
      for (int o = 1; o < 64; o <<= 1) { const float t = __shfl_up(bc, o); if (lane >= o) bc += t; }
      float am = gi - bc;
#pragma unroll
      for (int o = 32; o >= 1; o >>= 1) am = fmaxf(am, __shfl_xor(am, o));
      if (lane == 63) { s_sum[2 * cc] = bc; s_sum[2 * cc + 1] = am; }
    }
#pragma unroll
    for (int q = 0; q < 2; ++q) {
      const int cc = c0 + 2 * wid + q;
      float bc = gb[(size_t)(cc * 64 + lane) * 8 + 4 + h]; const float gi = gb[(size_t)(cc * 64 + lane) * 8 + h];
#pragma unroll
      for (int o = 1; o < 64; o <<= 1) { const float t = __shfl_up(bc, o); if (lane >= o) bc += t; }
      const float a = gi - bc;
      float cm = a;
#pragma unroll
      for (int o = 1; o < 64; o <<= 1) { const float t = __shfl_up(cm, o); if (lane >= o) cm = fmaxf(cm, t); }
      bcv[q] = bc; av[q] = a; cmv[q] = cm;
      if (lane == 63) { s_sum[2 * cc] = bc; s_sum[2 * cc + 1] = cm; }
    }
    __syncthreads();
    float m_prev = 0.f;
    for (int cc = 0; cc < c0 + 2 * wid; ++cc) m_prev = s_sum[2 * cc] + fmaxf(m_prev, s_sum[2 * cc + 1]);
#pragma unroll
    for (int q = 0; q < 2; ++q) {
      float* sm = scn + (2 * wid + q) * 448;
      const float M = fmaxf(m_prev, cmv[q]);
      const float M63 = __shfl(M, 63), bl = __shfl(bcv[q], 63);
      sm[lane] = av[q] * LOG2E; sm[64 + lane] = M * LOG2E; sm[128 + lane] = __expf(m_prev - M); sm[192 + lane] = __expf(-(bcv[q] + M)); sm[256 + lane] = __expf(av[q] - M63);
      if (lane == 0) sm[384] = __expf(m_prev - M63);
      m_prev = bl + M63;
    }
    __syncthreads();
  }
  const int erow = tid >> 3, epart = tid & 7;
  MlRegs R;
  const bf16_t* kt = p.hn + (size_t)b * SEQ * 512;
  ml_load_chunk<MODE>(R, ub, kt, gb, c0, h, wid, lane, erow, epart);
  for (int c = c0; c < c0 + 16; ++c) {
    float* sm = scn + (c - c0) * 448;
    float* s_a2 = sm, *s_M2 = sm + 64, *s_gi = sm + 128, *s_en = sm + 192, *s_w = sm + 256, *s_den = sm + 320, *s_misc = sm + 384;
    __syncthreads();
    {
      float wv[8];
#pragma unroll
      for (int j = 0; j < 8; ++j) wv[j] = s_w[8 * wid + j];
      float kq[8][2];
      u32x4 kw0, kw1, v0, v1;
      f32x2 cwq[5], cwk[5];
#pragma unroll
      for (int t = 0; t < 5; ++t) { cwq[t] = *(const f32x2*)(s_cw + t * 256 + 2 * lane); cwk[t] = *(const f32x2*)(s_cw + t * 256 + 128 + 2 * lane); }
#pragma unroll
      for (int j = 0; j < 8; ++j) {
        float aq0 = cwq[4][0], aq1 = cwq[4][1], ak0 = cwk[4][0], ak1 = cwk[4][1];
#pragma unroll
        for (int t = 0; t < 4; ++t) {
          if (MODE == 1) { aq0 += cwq[t][0] * bflo(R.rq[j + t]); aq1 += cwq[t][1] * bfhi(R.rq[j + t]); }
          else { ak0 += cwk[t][0] * bflo(R.rk[j + t]); ak1 += cwk[t][1] * bfhi(R.rk[j + t]); }
        }
        float sk0, sk1;
        if (MODE == 1) { sk0 = bflo(R.rk[j]); sk1 = bfhi(R.rk[j]); }
        else {
          sk0 = siluf(ak0); sk1 = siluf(ak1);
          const unsigned pk = pack2(sk0, sk1);
          *(unsigned*)(const_cast<bf16_t*>(kt) + (size_t)(c * 64 + 8 * wid + j) * 512 + h * 128 + 2 * lane) = pk;
          sk0 = bflo(pk); sk1 = bfhi(pk);
        }
        if (MODE == 1) {
          const float sq0 = siluf(aq0) * 0.08838834764831845f, sq1 = siluf(aq1) * 0.08838834764831845f;
          *(unsigned*)(qs + (8 * wid + j) * QST + 2 * lane) = pack2(sq0, sq1);
          *(unsigned*)(ks + (8 * wid + j) * QST + 2 * lane) = pack2(sk0, sk1);
        }
        kq[j][0] = sk0 * wv[j]; kq[j][1] = sk1 * wv[j];
      }
#pragma unroll
      for (int j = 0; j < 4; ++j) {
        kw0[j] = pack2(kq[2 * j][0], kq[2 * j + 1][0]); kw1[j] = pack2(kq[2 * j][1], kq[2 * j + 1][1]);
        v0[j] = (R.rv[2 * j] & 0xFFFFu) | (R.rv[2 * j + 1] << 16); v1[j] = (R.rv[2 * j] >> 16) | (R.rv[2 * j + 1] & 0xFFFF0000u);
      }
      *(u32x4*)(kwT + (2 * lane) * KST + 8 * wid) = kw0; *(u32x4*)(kwT + (2 * lane + 1) * KST + 8 * wid) = kw1;
      *(u32x4*)(vT + (2 * lane) * KST + 8 * wid) = v0;   *(u32x4*)(vT + (2 * lane + 1) * KST + 8 * wid) = v1;
    }
    __builtin_amdgcn_sched_barrier(0);
    if (c + 1 < c0 + 16) ml_load_chunk<MODE>(R, ub, kt, gb, c + 1, h, wid, lane, erow, epart);
    __syncthreads();
    if constexpr (MODE == 1) {
    const bf16_t* op = ub + (size_t)(c * 64 + erow) * NU + 3584 + h * 128 + 16 * epart;
    const u32x4 o0 = *(const u32x4*)(op), o1 = *(const u32x4*)(op + 8), z0 = *(const u32x4*)(op + 512), z1 = *(const u32x4*)(op + 520);
    {
#pragma unroll
      for (int q = 0; q < 2; ++q) {
        const int idx = 2 * wid + q, st = idx >> 2, lt = idx & 3;
        f32x4 acc = (f32x4){0.f, 0.f, 0.f, 0.f};
        if (st <= lt) {
#pragma unroll
          for (int kk = 0; kk < 4; ++kk) {
            const bf16x8 af = *(const bf16x8*)(ks + (16 * st + r16) * QST + 32 * kk + 8 * q4);
            const bf16x8 bfm = *(const bf16x8*)(qs + (16 * lt + r16) * QST + 32 * kk + 8 * q4);
            acc = __builtin_amdgcn_mfma_f32_16x16x32_bf16(af, bfm, acc, 0, 0, 0);
          }
          const int l = 16 * lt + r16; const float M2 = s_M2[l];
          const f32x4 a2 = *(const f32x4*)(s_a2 + 16 * st + 4 * q4);
#pragma unroll
          for (int i = 0; i < 4; ++i) { const int s = 16 * st + 4 * q4 + i; acc[i] = (s <= l) ? acc[i] * __builtin_amdgcn_exp2f(a2[i] - M2) : 0.f; }
        }
        u32x2 o; o[0] = pack2(acc[0], acc[1]); o[1] = pack2(acc[2], acc[3]);
        *(u32x2*)(scm + (16 * lt + r16) * KST + 16 * st + 4 * q4) = o;
      }
    }
    f32x4 oacc[5];
#pragma unroll
    for (int i = 0; i < 5; ++i) oacc[i] = (f32x4){0.f, 0.f, 0.f, 0.f};
    {
      bf16x8 bfr[4];
#pragma unroll
      for (int kk = 0; kk < 4; ++kk) bfr[kk] = *(const bf16x8*)(CT + (16 * wid + r16) * QST + 32 * kk + 8 * q4);
#pragma unroll
      for (int lt = 0; lt < 4; ++lt)
#pragma unroll
        for (int kk = 0; kk < 4; ++kk) {
          const bf16x8 af = *(const bf16x8*)(qs + (16 * lt + r16) * QST + 32 * kk + 8 * q4);
          oacc[lt] = __builtin_amdgcn_mfma_f32_16x16x32_bf16(af, bfr[kk], oacc[lt], 0, 0, 0);
        }
      if (wid < 4) {
#pragma unroll
        for (int kk = 0; kk < 4; ++kk) {
          const bf16x8 af = *(const bf16x8*)(qs + (16 * wid + r16) * QST + 32 * kk + 8 * q4);
          const bf16x8 bd = *(const bf16x8*)(CT + (128 + r16) * QST + 32 * kk + 8 * q4);
          oacc[4] = __builtin_amdgcn_mfma_f32_16x16x32_bf16(af, bd, oacc[4], 0, 0, 0);
        }
      }
    }
    __syncthreads();
    {
#pragma unroll
      for (int lt = 0; lt < 4; ++lt) { const f32x4 g = *(const f32x4*)(s_gi + 16 * lt + 4 * q4); oacc[lt] *= g; }
      if (wid < 4) { const f32x4 g = *(const f32x4*)(s_gi + 16 * wid + 4 * q4); oacc[4] *= g; }
      bf16x8 bv[2];
#pragma unroll
      for (int kk = 0; kk < 2; ++kk) bv[kk] = *(const bf16x8*)(vT + (16 * wid + r16) * KST + 32 * kk + 8 * q4);
#pragma unroll
      for (int lt = 0; lt < 4; ++lt)
#pragma unroll
        for (int kk = 0; kk < 2; ++kk) {
          const bf16x8 af = *(const bf16x8*)(scm + (16 * lt + r16) * KST + 32 * kk + 8 * q4);
          oacc[lt] = __builtin_amdgcn_mfma_f32_16x16x32_bf16(af, bv[kk], oacc[lt], 0, 0, 0);
        }
      if (wid < 4) {
#pragma unroll
        for (int kk = 0; kk < 2; ++kk) {
          const bf16x8 af = *(const bf16x8*)(scm + (16 * wid + r16) * KST + 32 * kk + 8 * q4);
          const bf16x8 bd = *(const bf16x8*)(vT + (128 + r16) * KST + 32 * kk + 8 * q4);
          oacc[4] = __builtin_amdgcn_mfma_f32_16x16x32_bf16(af, bd, oacc[4], 0, 0, 0);
        }
      }
#pragma unroll
      for (int lt = 0; lt < 4; ++lt)
#pragma unroll
        for (int i = 0; i < 4; ++i) num[(16 * lt + 4 * q4 + i) * NST + 16 * wid + r16] = oacc[lt][i];
      if (wid < 4 && r16 == 0) {
#pragma unroll
        for (int i = 0; i < 4; ++i) s_den[16 * wid + 4 * q4 + i] = oacc[4][i];
      }
    }
    {
      const float gc = s_misc[0];
      bf16x8 ak[2];
#pragma unroll
      for (int kk = 0; kk < 2; ++kk) ak[kk] = *(const bf16x8*)(kwT + (16 * wid + r16) * KST + 32 * kk + 8 * q4);
#pragma unroll
      for (int et = 0; et < 9; ++et) {
        Cst[et] *= gc;
#pragma unroll
        for (int kk = 0; kk < 2; ++kk) {
          const bf16x8 bvv = *(const bf16x8*)(vT + (16 * et + r16) * KST + 32 * kk + 8 * q4);
          Cst[et] = __builtin_amdgcn_mfma_f32_16x16x32_bf16(ak[kk], bvv, Cst[et], 0, 0, 0);
        }
        if constexpr (MODE == 1) {
          u32x2 o; o[0] = pack2(Cst[et][0], Cst[et][1]); o[1] = pack2(Cst[et][2], Cst[et][3]);
          *(u32x2*)(CT + (16 * et + r16) * QST + 16 * wid + 4 * q4) = o;
        }
      }
    }
    __syncthreads();
    {
      const float den = s_den[erow], en = s_en[erow];
      const float inv = 1.0f / fmaxf(fabsf(den), en);
      float hv[16]; float ss = 0.f;
#pragma unroll
      for (int j = 0; j < 4; ++j) {
        const f32x4 n4 = *(const f32x4*)(num + erow * NST + 16 * epart + 4 * j);
#pragma unroll
        for (int i = 0; i < 4; ++i) { hv[4 * j + i] = n4[i] * inv; ss += hv[4 * j + i] * hv[4 * j + i]; }
      }
      ss += __shfl_xor(ss, 1); ss += __shfl_xor(ss, 2); ss += __shfl_xor(ss, 4);
      const float rs = rsqrtf(ss * (1.0f / 128.0f) + EPS);
      const float* gp = p.mlg + h * 128 + 16 * epart;
      u32x4 out[2];
#pragma unroll
      for (int j = 0; j < 8; ++j) {
        const unsigned ow = (j < 4) ? o0[j & 3] : o1[j & 3], zw = (j < 4) ? z0[j & 3] : z1[j & 3];
        const float y0 = hv[2 * j] * rs * gp[2 * j] * sigmf(bflo(ow)) * siluf(bflo(zw));
        const float y1 = hv[2 * j + 1] * rs * gp[2 * j + 1] * sigmf(bfhi(ow)) * siluf(bfhi(zw));
        out[j >> 2][j & 3] = pack2(y0, y1);
      }
      bf16_t* yp = p.y + ((size_t)b * SEQ + c * 64 + erow) * DM + 512 + h * 128 + 16 * epart;
      *(u32x4*)(yp) = out[0]; *(u32x4*)(yp + 8) = out[1];
    }
    } else {
    {
      __builtin_amdgcn_sched_barrier(0);
      const float gc = s_misc[0];
      bf16x8 ak[2];
#pragma unroll
      for (int kk = 0; kk < 2; ++kk) ak[kk] = *(const bf16x8*)(kwT + (16 * wid + r16) * KST + 32 * kk + 8 * q4);
#pragma unroll
      for (int et = 0; et < 9; ++et) {
        Cst[et] *= gc;
#pragma unroll
        for (int kk = 0; kk < 2; ++kk) {
          const bf16x8 bvv = *(const bf16x8*)(vT + (16 * et + r16) * KST + 32 * kk + 8 * q4);
          Cst[et] = __builtin_amdgcn_mfma_f32_16x16x32_bf16(ak[kk], bvv, Cst[et], 0, 0, 0);
        }
        if constexpr (MODE == 1) {
          u32x2 o; o[0] = pack2(Cst[et][0], Cst[et][1]); o[1] = pack2(Cst[et][2], Cst[et][3]);
          *(u32x2*)(CT + (16 * et + r16) * QST + 16 * wid + 4 * q4) = o;
        }
      }
    }
    }
  }
  if constexpr (MODE == 0) {
    float* lo = p.Lst + (size_t)item * (9 * 512 * 4);
#pragma unroll
    for (int et = 0; et < 9; ++et) *(f32x4*)(lo + (size_t)(et * 512 + tid) * 4) = Cst[et];
    if (tid == 0) { float gp = 1.f; for (int q = 0; q < 16; ++q) gp *= scn[q * 448 + 384]; p.gch[item] = gp; }
  }
  __syncthreads();
}


DI void ml_state_pass(const Params& p, int b, int h, int J, unsigned char* lds) {
  int tid_ = threadIdx.x; asm volatile("" : "+v"(tid_));
  const int tid = tid_, wid = tid >> 6, lane = tid & 63, r16 = lane & 15, q4 = lane >> 4;
  bf16_t* kwTb[2] = {(bf16_t*)(lds + ML_KWT), (bf16_t*)(lds + ML_SC)};
  bf16_t* vTb[2] = {(bf16_t*)(lds + ML_VT), (bf16_t*)(lds + ML_SC + 18432)};
  float* s_cw = (float*)(lds + ML_CW);
  float* scn = (float*)(lds + ML_SCN);
  const bf16_t* ub = p.u + (size_t)b * SEQ * NU;
  const float* gb = p.gates + (size_t)b * SEQ * 8;
  bf16_t* kt = p.hn + (size_t)b * SEQ * 512;
  const int c0 = J * 16, item = ((b * 4 + h) * 4 + J);
  __syncthreads();
  for (int i = tid; i < 1280; i += 512) { const int j = i >> 8, qk = (i >> 7) & 1, ch = i & 127; s_cw[i] = (j < 4) ? p.conv_w[j * 1024 + qk * 512 + h * 128 + ch] : p.conv_b[qk * 512 + h * 128 + ch]; }
  for (int i = tid; i < 16 * KST; i += 512) { const bf16_t v = (i < KST) ? (bf16_t)0x3F80 : (bf16_t)0; vTb[0][128 * KST + i] = v; vTb[1][128 * KST + i] = v; }
  f32x4 Cst[9];
#pragma unroll
  for (int e = 0; e < 9; ++e) Cst[e] = (f32x4){0.f, 0.f, 0.f, 0.f};
  {
    float* s_sum = (float*)(lds + ML_QS);
    float bcv[2], av[2], cmv[2];
    for (int cc = wid; cc < c0; cc += 8) {
      float bc = gb[(size_t)(cc * 64 + lane) * 8 + 4 + h]; const float gi = gb[(size_t)(cc * 64 + lane) * 8 + h];
#pragma unroll
      for (int o = 1; o < 64; o <<= 1) { const float t = __shfl_up(bc, o); if (lane >= o) bc += t; }
      float am = gi - bc;
#pragma unroll
      for (int o = 32; o >= 1; o >>= 1) am = fmaxf(am, __shfl_xor(am, o));
      if (lane == 63) { s_sum[2 * cc] = bc; s_sum[2 * cc + 1] = am; }
    }
#pragma unroll
    for (int q = 0; q < 2; ++q) {
      const int cc = c0 + 2 * wid + q;
      float bc = gb[(size_t)(cc * 64 + lane) * 8 + 4 + h]; const float gi = gb[(size_t)(cc * 64 + lane) * 8 + h];
#pragma unroll
      for (int o = 1; o < 64; o <<= 1) { const float t = __shfl_up(bc, o); if (lane >= o) bc += t; }
      const float a = gi - bc;
      float cm = a;
#pragma unroll
      for (int o = 1; o < 64; o <<= 1) { const float t = __shfl_up(cm, o); if (lane >= o) cm = fmaxf(cm, t); }
      bcv[q] = bc; av[q] = a; cmv[q] = cm;
      if (lane == 63) { s_sum[2 * cc] = bc; s_sum[2 * cc + 1] = cm; }
    }
    __syncthreads();
    float m_prev = 0.f;
    for (int cc = 0; cc < c0 + 2 * wid; ++cc) m_prev = s_sum[2 * cc] + fmaxf(m_prev, s_sum[2 * cc + 1]);
#pragma unroll
    for (int q = 0; q < 2; ++q) {
      float* sm = scn + (2 * wid + q) * 448;
      const float M = fmaxf(m_prev, cmv[q]);
      const float M63 = __shfl(M, 63), bl = __shfl(bcv[q], 63);
      sm[256 + lane] = __expf(av[q] - M63);
      if (lane == 0) sm[384] = __expf(m_prev - M63);
      m_prev = bl + M63;
    }
    __syncthreads();
  }
  unsigned rk[2][11], rv[2][8];
#pragma unroll
  for (int u = 0; u < 2; ++u) {
    const int base = (c0 + u) * 64 + 8 * wid;
#pragma unroll
    for (int j = 0; j < 11; ++j) { const int t = base - 3 + j; rk[u][j] = (t >= 0) ? *(const unsigned*)(ub + (size_t)t * NU + 2560 + h * 128 + 2 * lane) : 0u; }
#pragma unroll
    for (int j = 0; j < 8; ++j) rv[u][j] = *(const unsigned*)(ub + (size_t)(base + j) * NU + 3072 + h * 128 + 2 * lane);
  }
  for (int cp = 0; cp < 8; ++cp) {
    const int c = c0 + 2 * cp;
    __syncthreads();
    {
      f32x2 cwk[5];
#pragma unroll
      for (int t = 0; t < 5; ++t) cwk[t] = *(const f32x2*)(s_cw + t * 256 + 128 + 2 * lane);
#pragma unroll
      for (int u = 0; u < 2; ++u) {
        const float* s_w = scn + (2 * cp + u) * 448 + 256;
        float kq[8][2];
#pragma unroll
        for (int j = 0; j < 8; ++j) {
          float ak0 = cwk[4][0], ak1 = cwk[4][1];
#pragma unroll
          for (int t = 0; t < 4; ++t) { ak0 += cwk[t][0] * bflo(rk[u][j + t]); ak1 += cwk[t][1] * bfhi(rk[u][j + t]); }
          const unsigned pk = pack2(siluf(ak0), siluf(ak1));
          *(unsigned*)(kt + (size_t)((c + u) * 64 + 8 * wid + j) * 512 + h * 128 + 2 * lane) = pk;
          const float wj = s_w[8 * wid + j];
          kq[j][0] = bflo(pk) * wj; kq[j][1] = bfhi(pk) * wj;
        }
        u32x4 kw0, kw1, v0, v1;
#pragma unroll
        for (int j = 0; j < 4; ++j) {
          kw0[j] = pack2(kq[2 * j][0], kq[2 * j + 1][0]); kw1[j] = pack2(kq[2 * j][1], kq[2 * j + 1][1]);
          v0[j] = (rv[u][2 * j] & 0xFFFFu) | (rv[u][2 * j + 1] << 16); v1[j] = (rv[u][2 * j] >> 16) | (rv[u][2 * j + 1] & 0xFFFF0000u);
        }
        *(u32x4*)(kwTb[u] + (2 * lane) * KST + 8 * wid) = kw0; *(u32x4*)(kwTb[u] + (2 * lane + 1) * KST + 8 * wid) = kw1;
        *(u32x4*)(vTb[u] + (2 * lane) * KST + 8 * wid) = v0;   *(u32x4*)(vTb[u] + (2 * lane + 1) * KST + 8 * wid) = v1;
      }
    }
    __builtin_amdgcn_sched_barrier(0);
    if (cp < 7) {
#pragma unroll
      for (int u = 0; u < 2; ++u) {
        const int base = (c + 2 + u) * 64 + 8 * wid;
#pragma unroll
        for (int j = 0; j < 11; ++j) rk[u][j] = *(const unsigned*)(ub + (size_t)(base - 3 + j) * NU + 2560 + h * 128 + 2 * lane);
#pragma unroll
        for (int j = 0; j < 8; ++j) rv[u][j] = *(const unsigned*)(ub + (size_t)(base + j) * NU + 3072 + h * 128 + 2 * lane);
      }
    }
    __syncthreads();
#pragma unroll
    for (int u = 0; u < 2; ++u) {
      const float gc = scn[(2 * cp + u) * 448 + 384];
      bf16x8 ak[2];
#pragma unroll
      for (int kk = 0; kk < 2; ++kk) ak[kk] = *(const bf16x8*)(kwTb[u] + (16 * wid + r16) * KST + 32 * kk + 8 * q4);
#pragma unroll
      for (int et = 0; et < 9; ++et) {
        Cst[et] *= gc;
#pragma unroll
        for (int kk = 0; kk < 2; ++kk) {
          const bf16x8 bvv = *(const bf16x8*)(vTb[u] + (16 * et + r16) * KST + 32 * kk + 8 * q4);
          Cst[et] = __builtin_amdgcn_mfma_f32_16x16x32_bf16(ak[kk], bvv, Cst[et], 0, 0, 0);
        }
      }
    }
  }
  {
    float* lo = p.Lst + (size_t)item * (9 * 512 * 4);
#pragma unroll
    for (int et = 0; et < 9; ++et) *(f32x4*)(lo + (size_t)(et * 512 + tid) * 4) = Cst[et];
    if (tid == 0) { float gp = 1.f; for (int q = 0; q < 16; ++q) gp *= scn[q * 448 + 384]; p.gch[item] = gp; }
  }
  __syncthreads();
}

__global__ void __launch_bounds__(512, 2) mega(Params p) {
  extern __shared__ __attribute__((aligned(16))) unsigned char shm[];
  cg::grid_group grid = cg::this_grid();
  __shared__ uint4 xb_words;
  if (threadIdx.x == 0) xb_words = make_uint4(0u, 0u, 0u, 0u);
  __syncthreads();
  const XcdBarrier xb = xcd_barrier_post(p.bar, (volatile LAS unsigned*)&xb_words);
  if (p.bar == nullptr) grid.sync();
  phase_a(p, shm);
  xcd_barrier(xb);
  phase_b(p, shm);
  xcd_barrier(xb);
  {
    pg8::Gemm g{p.hn, p.w1t, NTOK, NU, DM};
    pg8::StaticOrder S; S.init(NTOK, NU, (int)gridDim.x, (int)blockIdx.x);
    EpiU E{p.u, p.qg, p.kg};
    pg8::gemm_phase<EpiU>((LAS unsigned char*)shm, g, S, E);
  }
  xcd_barrier(xb);
  {
    for (int it = blockIdx.x; it < 256; it += gridDim.x) ml_state_pass(p, it >> 4, (it >> 2) & 3, it & 3, shm);
    const int wid = threadIdx.x >> 6;
    bf16_t* wl = (bf16_t*)shm + wid * (32 * 72);
    for (int it = blockIdx.x; it < 1280; it += gridDim.x) { const int bh = it >> 4, q256 = it & 15; sb_wave(p, bh >> 3, bh & 7, q256 * 8 + wid, wl); }
  }
  xcd_barrier(xb);
  {
    for (int it = blockIdx.x; it < 256; it += gridDim.x) ml_super<1>(p, it >> 4, (it >> 2) & 3, it & 3, shm);
    const int wid = threadIdx.x >> 6;
    bf16_t* wl = (bf16_t*)shm + wid * (32 * 72);
    for (int it = 1280 + blockIdx.x; it < 2048; it += gridDim.x) { const int bh = it >> 4, q256 = it & 15; sb_wave(p, bh >> 3, bh & 7, q256 * 8 + wid, wl); }
  }
  xcd_barrier(xb);
  {
    pg8::Gemm g{p.y, p.w2t, NTOK, DM, DM};
    pg8::StaticOrder S; S.init(NTOK, DM, (int)gridDim.x, (int)blockIdx.x);
    EpiOut E{p.out, p.x, p.mod};
    pg8::gemm_phase<EpiOut>((LAS unsigned char*)shm, g, S, E);
  }
}

extern "C" void kernel_launch(void* const* d_in, const int* in_sizes, int n_in, void* d_out, int out_size, void* d_ws, size_t ws_size, hipStream_t stream) {
  constexpr size_t kDynLds = 163840 - 16;
  static int grid_blocks = 0;
  if (!grid_blocks) {
    int dev = 0, cus = 0, per_cu = 0;
    (void)hipGetDevice(&dev);
    (void)hipDeviceGetAttribute(&cus, hipDeviceAttributeMultiprocessorCount, dev);
    (void)hipFuncSetAttribute((const void*)mega, hipFuncAttributeMaxDynamicSharedMemorySize, (int)kDynLds);
    (void)hipOccupancyMaxActiveBlocksPerMultiprocessor(&per_cu, mega, 512, kDynLds);
    if (per_cu < 1) per_cu = 1;
    grid_blocks = cus * per_cu;
    if (grid_blocks > 256) grid_blocks = 256;
  }
  Params p{};
  p.x = (const float*)d_in[0]; p.c = (const float*)d_in[1]; p.w_ada = (const float*)d_in[2]; p.b_ada = (const float*)d_in[3];
  p.norm_gain = (const float*)d_in[4]; p.w_in = (const float*)d_in[5]; p.b_gates = (const float*)d_in[6]; p.qg = (const float*)d_in[7];
  p.kg = (const float*)d_in[8]; p.conv_w = (const float*)d_in[9]; p.conv_b = (const float*)d_in[10]; p.mlg = (const float*)d_in[11];
  p.w_out = (const float*)d_in[12];
  p.out = (float*)d_out;
  unsigned char* w = (unsigned char*)d_ws; size_t off = 0;
  auto take = [&](size_t bytes) { unsigned char* r = w + off; off += (bytes + 255) & ~(size_t)255; return r; };
  p.bar = (unsigned*)take(XCD_BAR_WORDS * 4);
  p.mod = (float*)take(16 * 3072 * 4);
  p.gates = (float*)take((size_t)NTOK * 8 * 4);
  (void)take(4096 * 4); p.gch = (float*)take(4096 * 4);
  p.Lst = (float*)take((size_t)256 * 4608 * 16); (void)take((size_t)256 * 4608 * 16);
  p.w1t = (bf16_t*)take((size_t)NU * 1024 * 2);
  p.w2t = (bf16_t*)take((size_t)1024 * 1024 * 2);
  p.hn = (bf16_t*)take((size_t)NTOK * DM * 2);
  p.u = (bf16_t*)take((size_t)NTOK * NU * 2);
  p.y = (bf16_t*)take((size_t)NTOK * DM * 2);
  (void)hipMemsetAsync(p.bar, 0, XCD_BAR_WORDS * 4, stream);
  void* args[] = {&p};
  hipError_t e = hipLaunchCooperativeKernel((void*)mega, dim3(grid_blocks), dim3(512), args, kDynLds, stream);
  if (e != hipSuccess) fprintf(stderr, "cooperative launch failed: %s (grid %d)\n", hipGetErrorString(e), grid_blocks);
}
```
